# Optimizing an MI355X kernel written in HIP

```python
import math
import jax, jax.numpy as jnp
from jax import lax
import numpy as np

D_MODEL = 1024
BATCH = 2
SEQ = 16384
DEPTH = 2
DEC_BATCH = 16
DEC_SEQ = 2048
PAST_LEN = 128

N_MIXERS = 2
N_ATTN_LAYERS = (DEPTH + 1) // 2
N_POOL_LAYERS = DEPTH // 2
EXPAND = 2
BRANCH_WIDTH = EXPAND * D_MODEL
HEAD_DIM = 128
N_HEADS = BRANCH_WIDTH // HEAD_DIM
N_KV_HEADS = 4
GQA_GROUP = N_HEADS // N_KV_HEADS
Q_WIDTH = N_HEADS * HEAD_DIM
KV_WIDTH = N_KV_HEADS * HEAD_DIM
ATTN_IN = Q_WIDTH + 2 * KV_WIDTH + BRANCH_WIDTH
WINDOW = 128
BLOCK = 128
ROT_DIM = HEAD_DIM // 4
ROPE_THETA = 500000.0
POOL_WINDOWS = (2, 4, 8, 16)
N_POOL_GROUPS = len(POOL_WINDOWS)
POOL_GROUP_DIM = BRANCH_WIDTH // N_POOL_GROUPS
POOL_IN = 2 * BRANCH_WIDTH
NORM_EPS = 1e-6
NEG_INF = -1e30

kernel_name = "hybrid_window_gqa_multiscale_pool_encoder"


def rms_norm(x, gain):
    xf = x.astype(jnp.float32)
    y = xf * lax.rsqrt(jnp.mean(xf * xf, axis=-1, keepdims=True) + NORM_EPS)
    return (y * gain.astype(jnp.float32)).astype(x.dtype)


def partial_rope(x, pos):
    half = ROT_DIM // 2
    inv_freq = jnp.float32(ROPE_THETA) ** (-(jnp.arange(half, dtype=jnp.float32) * 2.0 / ROT_DIM))
    ang = pos[:, None] * inv_freq[None, :]
    cos = jnp.cos(ang)[None, :, None, :]
    sin = jnp.sin(ang)[None, :, None, :]
    xr = x[..., :ROT_DIM].astype(jnp.float32)
    x1, x2 = xr[..., :half], xr[..., half:]
    rot = jnp.concatenate([x1 * cos - x2 * sin, x2 * cos + x1 * sin], axis=-1)
    return jnp.concatenate([rot.astype(x.dtype), x[..., ROT_DIM:]], axis=-1)


def banded_window_attention(q, k, v, sink):
    B, S = q.shape[0], q.shape[1]
    nb = S // BLOCK
    pad = ((0, 0), (BLOCK, BLOCK), (0, 0), (0, 0))
    kp = jnp.pad(k, pad).reshape(B, nb + 2, BLOCK, N_KV_HEADS, HEAD_DIM)
    vp = jnp.pad(v, pad).reshape(B, nb + 2, BLOCK, N_KV_HEADS, HEAD_DIM)
    kwin = jnp.concatenate([kp[:, 0:nb], kp[:, 1:nb + 1], kp[:, 2:nb + 2]], axis=2)
    vwin = jnp.concatenate([vp[:, 0:nb], vp[:, 1:nb + 1], vp[:, 2:nb + 2]], axis=2)
    qpos = jnp.arange(S).reshape(nb, BLOCK)
    kpos = jnp.arange(nb)[:, None] * BLOCK - BLOCK + jnp.arange(3 * BLOCK)[None, :]
    valid = ((jnp.abs(qpos[:, :, None] - kpos[:, None, :]) <= WINDOW)
             & (kpos >= 0)[:, None, :] & (kpos < S)[:, None, :])
    scale = 1.0 / math.sqrt(HEAD_DIM)
    qb = q.reshape(B, nb, BLOCK, N_KV_HEADS, GQA_GROUP, HEAD_DIM)
    qh = jnp.moveaxis(qb, 3, 0)
    kh = jnp.moveaxis(kwin, 3, 0)
    vh = jnp.moveaxis(vwin, 3, 0)
    sh = sink.reshape(N_KV_HEADS, GQA_GROUP)

    def one_kv_head(args):
        qg, kg, vg, sg = args
        s = jnp.einsum('bnqgd,bnkd->bngqk', qg.astype(jnp.float32), kg.astype(jnp.float32)) * scale
        s = jnp.where(valid[None, :, None], s, NEG_INF)
        sl = sg.astype(jnp.float32)[None, None, :, None, None]
        m = jnp.maximum(jnp.max(s, axis=-1, keepdims=True), sl)
        p = jnp.exp(s - m)
        denom = jnp.sum(p, axis=-1, keepdims=True) + jnp.exp(sl - m)
        o = jnp.einsum('bngqk,bnkd->bnqgd', p / denom, vg.astype(jnp.float32))
        return o.astype(q.dtype)

    out = lax.map(one_kv_head, (qh, kh, vh, sh))
    out = jnp.moveaxis(out, 0, 3)
    return out.reshape(B, S, N_HEADS * HEAD_DIM)


def attention_branch(h, w_in, sink, w_out):
    B, S, _ = h.shape
    proj = h @ w_in
    q, k, v, gate = jnp.split(proj, [Q_WIDTH, Q_WIDTH + KV_WIDTH, Q_WIDTH + 2 * KV_WIDTH], axis=-1)
    q = q.reshape(B, S, N_HEADS, HEAD_DIM)
    k = k.reshape(B, S, N_KV_HEADS, HEAD_DIM)
    v = v.reshape(B, S, N_KV_HEADS, HEAD_DIM)
    pos = jnp.arange(S, dtype=jnp.float32)
    q = partial_rope(q, pos)
    k = partial_rope(k, pos)
    o = banded_window_attention(q, k, v, sink)
    return (o * jax.nn.silu(gate)) @ w_out


def pool_branch(h, w_in, w_group, scale, w_out):
    B, S, _ = h.shape
    u, gate = jnp.split(h @ w_in, 2, axis=-1)
    uf = u.astype(jnp.float32)
    csum = jnp.concatenate([jnp.zeros((B, 1, BRANCH_WIDTH), jnp.float32),
                            jnp.cumsum(uf, axis=1)], axis=1)
    idx = jnp.arange(S)
    groups = []
    for g, w in enumerate(POOL_WINDOWS):
        sl = slice(g * POOL_GROUP_DIM, (g + 1) * POOL_GROUP_DIM)
        lo = jnp.maximum(idx - w // 2, 0)
        hi = jnp.minimum(idx + w // 2 - 1, S - 1)
        cg = csum[..., sl]
        cnt = (hi - lo + 1).astype(jnp.float32)[None, :, None]
        mean = (jnp.take(cg, hi + 1, axis=1) - jnp.take(cg, lo, axis=1)) / cnt
        groups.append(mean - uf[..., sl])
    pooled = jnp.stack(groups, axis=2).astype(h.dtype)
    mixed = jnp.einsum('bsgc,gcd->bsgd', pooled, w_group).reshape(B, S, BRANCH_WIDTH) * scale
    return (mixed * jax.nn.silu(gate)) @ w_out


def trunk(x, norm_pre, norm_post, attn_w_in, attn_sink, attn_w_out,
          pool_w_in, pool_w_group, pool_scale, pool_w_out):
    for i in range(DEPTH):
        h = rms_norm(x, norm_pre[i])
        j = i // N_MIXERS
        if i % N_MIXERS == 0:
            out = attention_branch(h, attn_w_in[j], attn_sink[j], attn_w_out[j])
        else:
            out = pool_branch(h, pool_w_in[j], pool_w_group[j], pool_scale[j], pool_w_out[j])
        x = x + rms_norm(out, norm_post[i])
    return x


def setup_inputs(seed: int = 0) -> dict:
    key = jax.random.key(seed)
    ks = jax.random.split(key, 13)
    f32 = jnp.float32
    return {
        "x_prompt": jax.random.normal(ks[0], (BATCH, SEQ, D_MODEL), f32),
        "x_sample": jax.random.normal(ks[1], (DEC_BATCH, DEC_SEQ, D_MODEL), f32),
        "norm_pre": 1.0 + 0.05 * jax.random.normal(ks[2], (DEPTH, D_MODEL), f32),
        "norm_post": 1.0 + 0.05 * jax.random.normal(ks[3], (DEPTH, D_MODEL), f32),
        "attn_w_in": jax.random.normal(ks[4], (N_ATTN_LAYERS, D_MODEL, ATTN_IN), f32) * D_MODEL ** -0.5,
        "attn_sink": 0.5 * jax.random.normal(ks[5], (N_ATTN_LAYERS, N_HEADS), f32),
        "attn_w_out": jax.random.normal(ks[6], (N_ATTN_LAYERS, BRANCH_WIDTH, D_MODEL), f32) * BRANCH_WIDTH ** -0.5,
        "pool_w_in": jax.random.normal(ks[7], (N_POOL_LAYERS, D_MODEL, POOL_IN), f32) * D_MODEL ** -0.5,
        "pool_w_group": jax.random.normal(ks[8], (N_POOL_LAYERS, N_POOL_GROUPS, POOL_GROUP_DIM, POOL_GROUP_DIM), f32) * POOL_GROUP_DIM ** -0.5,
        "pool_scale": 1.0 + 0.1 * jax.random.normal(ks[9], (N_POOL_LAYERS, BRANCH_WIDTH), f32),
        "pool_w_out": jax.random.normal(ks[10], (N_POOL_LAYERS, BRANCH_WIDTH, D_MODEL), f32) * BRANCH_WIDTH ** -0.5,
    }


def reference(x_prompt, x_sample, norm_pre, norm_post, attn_w_in, attn_sink, attn_w_out,
              pool_w_in, pool_w_group, pool_scale, pool_w_out):
    y_prompt = trunk(x_prompt, norm_pre, norm_post, attn_w_in, attn_sink, attn_w_out,
                     pool_w_in, pool_w_group, pool_scale, pool_w_out)
    y_sample = trunk(x_sample, norm_pre, norm_post, attn_w_in, attn_sink, attn_w_out,
                     pool_w_in, pool_w_group, pool_scale, pool_w_out)
    return (y_prompt, y_sample)
```

```cpp
#include <hip/hip_runtime.h>
#include <hip/hip_cooperative_groups.h>
#include <cstdio>
#include <cstdint>
namespace cg = cooperative_groups;

#define LAS __attribute__((address_space(3)))
typedef unsigned short bf16_t;
typedef short bf16x8 __attribute__((ext_vector_type(8)));
typedef short s16x4 __attribute__((ext_vector_type(4)));
typedef float f32x4 __attribute__((ext_vector_type(4)));
typedef float f32x16 __attribute__((ext_vector_type(16)));
typedef unsigned u32x4 __attribute__((ext_vector_type(4)));
typedef unsigned u32x2 __attribute__((ext_vector_type(2)));

constexpr int DM = 1024;
constexpr int MH = 32768;
constexpr int NQKVG = 5120;
constexpr int NUG = 4096;
constexpr float NORM_EPS = 1e-6f;
constexpr float LOG2E = 1.4426950408889634f;
constexpr float QSCALE = 1.4426950408889634f * 0.08838834764831845f;

constexpr size_t MiB = 1u << 20;
constexpr size_t WS_WIN = 1 * MiB;
constexpr size_t WS_WO = 11 * MiB;
constexpr size_t WS_PIN = 15 * MiB;
constexpr size_t WS_WG = 23 * MiB;
constexpr size_t WS_PO = 25 * MiB;
constexpr size_t WS_CS = 29 * MiB;
constexpr size_t WS_SS0 = 31 * MiB;
constexpr size_t WS_SS1 = 33 * MiB;
constexpr size_t WS_XN = 40 * MiB;
constexpr size_t WS_BIG = 104 * MiB;
constexpr size_t WS_POOL = 360 * MiB;
constexpr size_t WS_OUT = 424 * MiB;
constexpr size_t WS_END = 488 * MiB;

namespace pg8 {
constexpr int BM = 256, BK = 64, HALF = 128, HTB = HALF * BK * 2, STAGE_BYTES = 8 * HTB, NXCD = 8, WGM = 8;
__device__ __forceinline__ int lds_byte(int r, int c) { const int st = (r >> 4) * 2 + (c >> 5), rr = r & 15, cc = c & 31, ob = rr * 64 + cc * 2; return st * 1024 + (ob ^ (((ob >> 9) & 1) << 5)); }
__device__ __forceinline__ void stage_rc(int b, int& R, int& C) { const int st = b / 1024, sb = b % 1024, swz = sb ^ (((sb >> 9) & 1) << 5); R = (st >> 1) * 16 + swz / 64; C = (st & 1) * 32 + (swz % 64) / 2; }
__device__ __forceinline__ int perm32(int rho) { const int n = rho >> 4, i = rho & 15; return 8 * (i >> 2) + 4 * n + (i & 3); }

struct Unit { int pm, pn; };
struct Gemm { const bf16_t* A; const bf16_t* Bt; int lda, K; };

struct Order {
    int nM, nN, nwg, G, c, grouped;
    __device__ __forceinline__ bool next(int i, Unit& u) const {
        const long L = (long)i * G + c; if (L >= nwg) return false;
        if (grouped) { const int l = (int)L, g = l >> 8, rem = l & 255; u.pm = g * 128 + (rem & 127); u.pn = g * 2 + (rem >> 7); return true; }
        int wgid = (int)L; { const int q = nwg / NXCD, r = nwg % NXCD, xcd = wgid % NXCD, off = wgid / NXCD; wgid = (xcd < r ? xcd * (q + 1) : r * (q + 1) + (xcd - r) * q) + off; }
        const int nig = WGM * nN, gid = wgid / nig, fm = gid * WGM, gsz = (nM - fm) < WGM ? (nM - fm) : WGM;
        u.pm = fm + ((wgid % nig) % gsz); u.pn = (wgid % nig) / gsz; return true;
    }
};

__device__ __forceinline__ unsigned cvt_pk_bf16(float lo, float hi) { unsigned r; asm volatile("v_cvt_pk_bf16_f32 %0, %1, %2" : "=v"(r) : "v"(lo), "v"(hi)); return r; }
__device__ __forceinline__ float bf_lo(unsigned w) { return __uint_as_float(w << 16); }
__device__ __forceinline__ float bf_hi(unsigned w) { return __uint_as_float(w & 0xffff0000u); }
__device__ __forceinline__ float silu_f(float g) { return g * __builtin_amdgcn_rcpf(1.0f + __builtin_amdgcn_exp2f(-g * LOG2E)); }

struct Epi {
    int mode;
    bf16_t* O; int ldc;
    const float* cs; int smask;
    float* ss;
    const float* scale;
    __device__ __forceinline__ void operator()(const f32x4 (&acc)[2][2][4][2], const Unit& u, int wr, int wc, int fr, int fq) const {
        int pm = u.pm; if (mode == 3) pm &= 127;
        const int row0 = pm * BM + wr * 64 + fr, col0 = u.pn * BM + wc * 32 + 8 * fq;
        if (mode == 0) {
            const int kind = u.pn < 8 ? 0 : (u.pn < 10 ? 1 : 2);
            const float sc = kind == 0 ? QSCALE : 1.0f;
            const bool rope = (kind < 2) && (wc == 0);
#pragma unroll
            for (int ai = 0; ai < 2; ++ai)
#pragma unroll
                for (int m = 0; m < 4; ++m) {
                    const int row = row0 + ai * HALF + m * 16;
                    f32x4 c4 = (f32x4){1.f, 1.f, 1.f, 1.f}, s4 = (f32x4){0.f, 0.f, 0.f, 0.f};
                    if (rope) { const float* t = cs + (size_t)(row & smask) * 32 + 4 * fq; c4 = *(const f32x4*)t; s4 = *(const f32x4*)(t + 16); }
                    bf16_t* rowp = O + (size_t)row * ldc + col0;
#pragma unroll
                    for (int bj = 0; bj < 2; ++bj) {
                        f32x4 v0 = acc[ai][bj][m][0], v1 = acc[ai][bj][m][1];
                        if (rope) { const f32x4 n0 = v0 * c4 - v1 * s4, n1 = v1 * c4 + v0 * s4; v0 = n0; v1 = n1; }
                        v0 = v0 * sc; v1 = v1 * sc;
                        u32x4 w; w.x = cvt_pk_bf16(v0[0], v0[1]); w.y = cvt_pk_bf16(v0[2], v0[3]); w.z = cvt_pk_bf16(v1[0], v1[1]); w.w = cvt_pk_bf16(v1[2], v1[3]);
                        *(u32x4*)(rowp + bj * HALF) = w;
                    }
                }
        } else if (mode == 1) {
#pragma unroll
            for (int ai = 0; ai < 2; ++ai)
#pragma unroll
                for (int m = 0; m < 4; ++m) {
                    bf16_t* rowp = O + (size_t)(row0 + ai * HALF + m * 16) * ldc + col0;
#pragma unroll
                    for (int bj = 0; bj < 2; ++bj) {
                        const f32x4 v0 = acc[ai][bj][m][0], v1 = acc[ai][bj][m][1];
                        u32x4 w; w.x = cvt_pk_bf16(v0[0], v0[1]); w.y = cvt_pk_bf16(v0[2], v0[3]); w.z = cvt_pk_bf16(v1[0], v1[1]); w.w = cvt_pk_bf16(v1[2], v1[3]);
                        *(u32x4*)(rowp + bj * HALF) = w;
                    }
                }
        } else if (mode == 2) {
#pragma unroll
            for (int ai = 0; ai < 2; ++ai)
#pragma unroll
                for (int m = 0; m < 4; ++m) {
                    const int row = row0 + ai * HALF + m * 16;
                    bf16_t* rowp = O + (size_t)row * ldc + col0;
                    float s = 0.f;
#pragma unroll
                    for (int bj = 0; bj < 2; ++bj) {
                        const f32x4 v0 = acc[ai][bj][m][0], v1 = acc[ai][bj][m][1];
                        s += (v0[0] * v0[0] + v0[1] * v0[1]) + (v0[2] * v0[2] + v0[3] * v0[3]) + (v1[0] * v1[0] + v1[1] * v1[1]) + (v1[2] * v1[2] + v1[3] * v1[3]);
                        u32x4 w; w.x = cvt_pk_bf16(v0[0], v0[1]); w.y = cvt_pk_bf16(v0[2], v0[3]); w.z = cvt_pk_bf16(v1[0], v1[1]); w.w = cvt_pk_bf16(v1[2], v1[3]);
                        *(u32x4*)(rowp + bj * HALF) = w;
                    }
                    s += __shfl_xor(s, 16); s += __shfl_xor(s, 32);
                    if (fq == 0) ss[(size_t)row * 16 + u.pn * 4 + wc] = s;
                }
        } else {
            f32x4 sv[2][2];
#pragma unroll
            for (int bj = 0; bj < 2; ++bj) { sv[bj][0] = *(const f32x4*)(scale + col0 + bj * HALF); sv[bj][1] = *(const f32x4*)(scale + col0 + bj * HALF + 4); }
#pragma unroll
            for (int ai = 0; ai < 2; ++ai)
#pragma unroll
                for (int m = 0; m < 4; ++m) {
                    bf16_t* rowp = O + (size_t)(row0 + ai * HALF + m * 16) * ldc + col0;
#pragma unroll
                    for (int bj = 0; bj < 2; ++bj) {
                        const u32x4 gw = *(const u32x4*)(rowp + 2048 + bj * HALF);
                        f32x4 v0 = acc[ai][bj][m][0] * sv[bj][0], v1 = acc[ai][bj][m][1] * sv[bj][1];
                        v0[0] *= silu_f(bf_lo(gw.x)); v0[1] *= silu_f(bf_hi(gw.x)); v0[2] *= silu_f(bf_lo(gw.y)); v0[3] *= silu_f(bf_hi(gw.y));
                        v1[0] *= silu_f(bf_lo(gw.z)); v1[1] *= silu_f(bf_hi(gw.z)); v1[2] *= silu_f(bf_lo(gw.w)); v1[3] *= silu_f(bf_hi(gw.w));
                        u32x4 w; w.x = cvt_pk_bf16(v0[0], v0[1]); w.y = cvt_pk_bf16(v0[2], v0[3]); w.z = cvt_pk_bf16(v1[0], v1[1]); w.w = cvt_pk_bf16(v1[2], v1[3]);
                        *(u32x4*)(rowp + bj * HALF) = w;
                    }
                }
        }
    }
};

__device__ __forceinline__ void gemm_phase(LAS unsigned char* lds, const Gemm g, const Order& S, const Epi& E) {
    int tid_ = threadIdx.x; asm volatile("" : "+v"(tid_));
    const int tid = tid_, wid = __builtin_amdgcn_readfirstlane(tid >> 6), lane = tid & 63, wr = wid >> 2, wc = wid & 3, fr = lane & 15, fq = lane >> 4;
    const int K = g.K, nt = K / BK, lda = g.lda;
    unsigned voffA[2], voffB[2];
#pragma unroll
    for (int i = 0; i < 2; ++i) { int R, C; stage_rc(tid * 16 + i * 8192, R, C); const int Rb = (R & ~31) + perm32(R & 31);
        voffA[i] = (unsigned)(R * lda + C) * 2u; voffB[i] = (unsigned)(Rb * K + C) * 2u; }
    const size_t kstep = (size_t)(BK * 2);
    const size_t hstepA = (size_t)HALF * lda * 2, hstepB = (size_t)HALF * K * 2;
    const size_t tstepA = 2 * hstepA, tstepB = 2 * hstepB;
    const unsigned ldsw = (unsigned)wid * 1024u;
    const int aoff = lds_byte(wr * 64 + fr, fq * 8), boff = lds_byte(wc * 32 + fr, fq * 8);
#define PG8_SA(b, h) (((b) * 2 + (h)) * HTB)
#define PG8_SB(b, h) ((4 + (b) * 2 + (h)) * HTB)
#define PG8_STAGE(bufoff, gbase, voff) do { _Pragma("unroll") for (int _i = 0; _i < 2; ++_i) \
        __builtin_amdgcn_global_load_lds((const unsigned*)((const char*)(gbase) + (voff)[_i]), (LAS unsigned*)(lds + (bufoff) + ldsw + _i * 8192), 16, 0, 0); } while (0)
#define PG8_LDA(dst, b, h) do { _Pragma("unroll") for (int m = 0; m < 4; ++m) _Pragma("unroll") for (int k = 0; k < 2; ++k) dst[m][k] = *(const LAS bf16x8*)(lds + PG8_SA(b, h) + aoff + m * 2048 + k * 1024); } while (0)
#define PG8_LDB(dst, b, h) do { _Pragma("unroll") for (int n = 0; n < 2; ++n) _Pragma("unroll") for (int k = 0; k < 2; ++k) dst[n][k] = *(const LAS bf16x8*)(lds + PG8_SB(b, h) + boff + n * 2048 + k * 1024); } while (0)
#define PG8_MMA(ai, bj, At, Bt) do { __builtin_amdgcn_s_setprio(1); _Pragma("unroll") for (int m = 0; m < 4; ++m) _Pragma("unroll") for (int n = 0; n < 2; ++n) _Pragma("unroll") for (int k = 0; k < 2; ++k) \
        acc[ai][bj][m][n] = __builtin_amdgcn_mfma_f32_16x16x32_bf16(Bt[n][k], At[m][k], acc[ai][bj][m][n], 0, 0, 0); __builtin_amdgcn_s_setprio(0); } while (0)
#define PG8_WAIT_V(n) asm volatile("s_waitcnt vmcnt(" #n ")" ::: "memory")
#define PG8_WAIT_L(n) asm volatile("s_waitcnt lgkmcnt(" #n ")" ::: "memory")
#define PG8_BAR __builtin_amdgcn_s_barrier()
#define PG8_SCHED __builtin_amdgcn_sched_barrier(0)
    Unit cur, nxt; int ui = 0;
    if (!S.next(0, cur)) return;
    f32x4 acc[2][2][4][2];
#pragma unroll
    for (int a = 0; a < 2; ++a)
#pragma unroll
        for (int b = 0; b < 2; ++b)
#pragma unroll
            for (int m = 0; m < 4; ++m)
#pragma unroll
                for (int n = 0; n < 2; ++n) acc[a][b][m][n] = (f32x4){0.f, 0.f, 0.f, 0.f};
    bf16x8 At[4][2], B0[2][2], B1[2][2];
    const char* cA = (const char*)g.A + (size_t)cur.pm * tstepA; const char* cB = (const char*)g.Bt + (size_t)cur.pn * tstepB;
    PG8_STAGE(PG8_SB(0, 0), cB, voffB); PG8_STAGE(PG8_SB(0, 1), cB + hstepB, voffB); PG8_STAGE(PG8_SA(0, 0), cA, voffA); PG8_STAGE(PG8_SA(0, 1), cA + hstepA, voffA);
    if (wr == 1) PG8_BAR;
    PG8_WAIT_V(2); PG8_BAR;
    PG8_STAGE(PG8_SB(1, 0), cB + kstep, voffB); PG8_STAGE(PG8_SA(1, 0), cA + kstep, voffA); PG8_STAGE(PG8_SB(1, 1), cB + hstepB + kstep, voffB);
    PG8_WAIT_V(6); PG8_BAR;
    for (;;) {
        const bool has_next = S.next(ui + 1, nxt);
        const char* nA = has_next ? (const char*)g.A + (size_t)nxt.pm * tstepA : cA; const char* nB = has_next ? (const char*)g.Bt + (size_t)nxt.pn * tstepB : cB;
        for (int t = 0; t < nt; t += 2) {
            const bool last = (t == nt - 2);
            const char* a1 = cA + (size_t)(t + 1) * kstep;
            const char* a2 = last ? nA : cA + (size_t)(t + 2) * kstep; const char* b2 = last ? nB : cB + (size_t)(t + 2) * kstep;
            const char* a3 = a2 + kstep; const char* b3 = b2 + kstep;
            PG8_LDB(B0, 0, 0); PG8_LDB(B1, 0, 1); PG8_SCHED; PG8_LDA(At, 0, 0); PG8_STAGE(PG8_SA(1, 1), a1 + hstepA, voffA);
            PG8_WAIT_V(8); PG8_WAIT_L(0); PG8_BAR; PG8_MMA(0, 0, At, B0); PG8_MMA(0, 1, At, B1); PG8_BAR; PG8_SCHED;
            PG8_LDA(At, 0, 1); PG8_STAGE(PG8_SB(0, 0), b2, voffB); PG8_STAGE(PG8_SB(0, 1), b2 + hstepB, voffB); PG8_STAGE(PG8_SA(0, 0), a2, voffA);
            PG8_WAIT_V(8); PG8_WAIT_L(0); PG8_BAR; PG8_MMA(1, 0, At, B0); PG8_MMA(1, 1, At, B1); PG8_BAR; PG8_SCHED;
            PG8_LDB(B0, 1, 0); PG8_LDB(B1, 1, 1); PG8_SCHED; PG8_LDA(At, 1, 0); PG8_STAGE(PG8_SA(0, 1), a2 + hstepA, voffA);
            PG8_WAIT_V(8); PG8_WAIT_L(0); PG8_BAR; PG8_MMA(0, 0, At, B0); PG8_MMA(0, 1, At, B1); PG8_BAR; PG8_SCHED;
            PG8_LDA(At, 1, 1); PG8_STAGE(PG8_SB(1, 0), b3, voffB); PG8_STAGE(PG8_SB(1, 1), b3 + hstepB, voffB); PG8_STAGE(PG8_SA(1, 0), a3, voffA);
            PG8_WAIT_V(8); PG8_WAIT_L(0); PG8_BAR; PG8_MMA(1, 0, At, B0); PG8_MMA(1, 1, At, B1); PG8_BAR; PG8_SCHED;
        }
        if (wr == 0) PG8_BAR;
        E(acc, cur, wr, wc, fr, fq);
        if (!has_next) break;
#pragma unroll
        for (int a = 0; a < 2; ++a)
#pragma unroll
            for (int b = 0; b < 2; ++b)
#pragma unroll
                for (int m = 0; m < 4; ++m)
#pragma unroll
                    for (int n = 0; n < 2; ++n) acc[a][b][m][n] = (f32x4){0.f, 0.f, 0.f, 0.f};
        cur = nxt; cA = nA; cB = nB; ++ui;
        if (wr == 1) PG8_BAR;
    }
    PG8_WAIT_V(0);
    PG8_BAR;
#undef PG8_SA
#undef PG8_SB
#undef PG8_STAGE
#undef PG8_LDA
#undef PG8_LDB
#undef PG8_MMA
#undef PG8_WAIT_V
#undef PG8_WAIT_L
#undef PG8_BAR
#undef PG8_SCHED
}
}

using pg8::cvt_pk_bf16; using pg8::bf_lo; using pg8::bf_hi; using pg8::silu_f;

__device__ __forceinline__ unsigned off_b(unsigned row, unsigned ch) { return 256u * row + 16u * (ch ^ (((row & 3) << 2) | ((row >> 2) & 3))); }
__device__ __forceinline__ int crow(int r, int hi) { return (r & 3) + 8 * (r >> 2) + 4 * hi; }

__device__ __forceinline__ void attn_phase(LAS unsigned char* lds, bf16_t* QKVG, const float* sink, int S, int G, int bid) {
    int tid_ = threadIdx.x; asm volatile("" : "+v"(tid_));
    const int tid = tid_, lane = tid & 63, wid = __builtin_amdgcn_readfirstlane(tid >> 6);
    const int r32 = lane & 31, hi = lane >> 5, hloc = wid & 3, sb = wid >> 2;
    const int q4 = (lane & 15) >> 2, blk = (lane >> 4) & 1, p4 = lane & 3;
    const unsigned so0 = off_b(tid >> 4, tid & 15);
    for (int unit = bid; unit < (MH / 64) * 4; unit += G) {
        const int kvh = unit & 3, qc = unit >> 2, q0 = qc * 64;
        const int seq0 = q0 & ~(S - 1), seq1 = seq0 + S, k0 = q0 - 128;
        const int cfirst = (q0 - seq0 >= 128) ? 0 : ((q0 - seq0 >= 64) ? 1 : 2);
        const int clast = (seq1 - q0 - 64 >= 128) ? 4 : ((seq1 - q0 - 64 >= 64) ? 3 : 2);
        const int hq = kvh * 4 + hloc, qrow = q0 + sb * 32 + r32;
        bf16x8 qf[8];
        { const bf16_t* qp = QKVG + (size_t)qrow * NQKVG + hq * 128 + hi * 8;
#pragma unroll
          for (int s = 0; s < 8; ++s) qf[s] = *(const bf16x8*)(qp + 16 * s); }
        const bf16_t* kvp = QKVG + ((long)k0 + (tid >> 4)) * NQKVG + 2048 + kvh * 128 + (tid & 15) * 8;
        float m = sink[hq] * LOG2E, l = (hi == 0) ? 1.0f : 0.0f;
        f32x16 o[4];
#pragma unroll
        for (int c = 0; c < 4; ++c)
#pragma unroll
            for (int r = 0; r < 16; ++r) o[c][r] = 0.f;
        u32x4 rk0, rk1, rv0, rv1;
        { const bf16_t* p = kvp + (long)(64 * cfirst) * NQKVG;
          rk0 = *(const u32x4*)p; rk1 = *(const u32x4*)(p + 32 * NQKVG); rv0 = *(const u32x4*)(p + 512); rv1 = *(const u32x4*)(p + 32 * NQKVG + 512);
          const unsigned kb = (cfirst & 1) * 32768u;
          *(LAS u32x4*)(lds + kb + so0) = rk0; *(LAS u32x4*)(lds + kb + so0 + 8192) = rk1;
          *(LAS u32x4*)(lds + kb + 16384 + so0) = rv0; *(LAS u32x4*)(lds + kb + 16384 + so0 + 8192) = rv1; }
        __syncthreads();
        for (int c = cfirst; c <= clast; ++c) {
            const bool more = c < clast;
            if (more) { const bf16_t* p = kvp + (long)(64 * (c + 1)) * NQKVG;
                rk0 = *(const u32x4*)p; rk1 = *(const u32x4*)(p + 32 * NQKVG); rv0 = *(const u32x4*)(p + 512); rv1 = *(const u32x4*)(p + 32 * NQKVG + 512); }
            const unsigned kb = (c & 1) * 32768u, vb = kb + 16384u;
#pragma unroll
            for (int tt = 0; tt < 2; ++tt) {
                const int lt = 2 * c + tt - sb;
                if (lt >= 0 && lt <= 8) {
                    f32x16 st;
#pragma unroll
                    for (int r = 0; r < 16; ++r) st[r] = 0.f;
#pragma unroll
                    for (int s = 0; s < 8; ++s) {
                        const bf16x8 kf = *(const LAS bf16x8*)(lds + kb + off_b(tt * 32 + r32, 2 * s + hi));
                        st = __builtin_amdgcn_mfma_f32_32x32x16_bf16(kf, qf[s], st, 0, 0, 0);
                    }
                    if (lt == 0) {
#pragma unroll
                        for (int r = 0; r < 16; ++r) if (crow(r, hi) < r32) st[r] = -1e30f;
                    } else if (lt == 8) {
#pragma unroll
                        for (int r = 0; r < 16; ++r) if (crow(r, hi) > r32) st[r] = -1e30f;
                    }
                    float rm = st[0];
#pragma unroll
                    for (int r = 1; r < 16; ++r) rm = fmaxf(rm, st[r]);
                    rm = fmaxf(rm, __shfl_xor(rm, 32));
                    const float mn = fmaxf(m, rm), alpha = __builtin_amdgcn_exp2f(m - mn);
                    m = mn;
                    float ps = 0.f;
#pragma unroll
                    for (int r = 0; r < 16; ++r) { st[r] = __builtin_amdgcn_exp2f(st[r] - mn); ps += st[r]; }
                    l = l * alpha + ps;
#pragma unroll
                    for (int cc = 0; cc < 4; ++cc)
#pragma unroll
                        for (int r = 0; r < 16; ++r) o[cc][r] *= alpha;
                    bf16x8 pf[2];
#pragma unroll
                    for (int s = 0; s < 2; ++s) {
                        u32x4 w; w.x = cvt_pk_bf16(st[8 * s + 0], st[8 * s + 1]); w.y = cvt_pk_bf16(st[8 * s + 2], st[8 * s + 3]);
                        w.z = cvt_pk_bf16(st[8 * s + 4], st[8 * s + 5]); w.w = cvt_pk_bf16(st[8 * s + 6], st[8 * s + 7]);
                        pf[s] = __builtin_bit_cast(bf16x8, w);
                    }
#pragma unroll
                    for (int cc = 0; cc < 4; ++cc)
#pragma unroll
                        for (int s = 0; s < 2; ++s) {
                            const unsigned a0 = vb + off_b(tt * 32 + 16 * s + 4 * hi + q4, 4 * cc + 2 * blk + (p4 >> 1)) + 8 * (p4 & 1);
                            const unsigned a1 = vb + off_b(tt * 32 + 16 * s + 8 + 4 * hi + q4, 4 * cc + 2 * blk + (p4 >> 1)) + 8 * (p4 & 1);
                            const s16x4 lo = __builtin_amdgcn_ds_read_tr16_b64_v4i16((LAS s16x4*)(lds + a0));
                            const s16x4 hh = __builtin_amdgcn_ds_read_tr16_b64_v4i16((LAS s16x4*)(lds + a1));
                            const bf16x8 vf = (bf16x8){lo[0], lo[1], lo[2], lo[3], hh[0], hh[1], hh[2], hh[3]};
                            o[cc] = __builtin_amdgcn_mfma_f32_32x32x16_bf16(vf, pf[s], o[cc], 0, 0, 0);
                        }
                }
            }
            if (more) { const unsigned nb = ((c + 1) & 1) * 32768u;
                *(LAS u32x4*)(lds + nb + so0) = rk0; *(LAS u32x4*)(lds + nb + so0 + 8192) = rk1;
                *(LAS u32x4*)(lds + nb + 16384 + so0) = rv0; *(LAS u32x4*)(lds + nb + 16384 + so0 + 8192) = rv1; }
            __syncthreads();
        }
        l += __shfl_xor(l, 32);
        const float inv = 1.0f / l;
        bf16_t* orow = QKVG + (size_t)qrow * NQKVG + hq * 128;
#pragma unroll
        for (int cc = 0; cc < 4; ++cc)
#pragma unroll
            for (int g4 = 0; g4 < 4; ++g4) {
                const int d = 32 * cc + 8 * g4 + 4 * hi;
                const u32x2 gw = *(const u32x2*)(orow + 3072 + d);
                const float v0 = o[cc][4 * g4 + 0] * inv * silu_f(bf_lo(gw.x)), v1 = o[cc][4 * g4 + 1] * inv * silu_f(bf_hi(gw.x));
                const float v2 = o[cc][4 * g4 + 2] * inv * silu_f(bf_lo(gw.y)), v3 = o[cc][4 * g4 + 3] * inv * silu_f(bf_hi(gw.y));
                u32x2 w; w.x = cvt_pk_bf16(v0, v1); w.y = cvt_pk_bf16(v2, v3);
                *(u32x2*)(orow + d) = w;
            }
    }
}

__device__ __forceinline__ float wave_sum(float v) {
#pragma unroll
    for (int o = 1; o < 64; o <<= 1) v += __shfl_xor(v, o);
    return v;
}
__device__ __forceinline__ unsigned f2bf(float f) { unsigned u = __builtin_bit_cast(unsigned, f); return (u + 0x7fffu + ((u >> 16) & 1u)) >> 16; }
__device__ __forceinline__ unsigned pk2(float lo, float hi) { return f2bf(lo) | (f2bf(hi) << 16); }

__device__ __forceinline__ void p0_transpose_item(const float* W, int K, int N, bf16_t* WT, int row_off, LAS float* scr, int item, int lane, int rope) {
    const int nblk = N / 32, kb = item / nblk, nb = item % nblk, k0 = 64 * kb, n0 = 32 * nb;
#pragma unroll 8
    for (int i = 0; i < 32; ++i) { const int kk = 2 * i + (lane >> 5); scr[kk * 33 + (lane & 31)] = W[(size_t)(k0 + kk) * N + n0 + (lane & 31)]; }
    asm volatile("s_waitcnt lgkmcnt(0)" ::: "memory");
    const bool perm = rope && ((n0 & 127) == 0) && (n0 < 2560);
    const int c = lane & 7;
#pragma unroll
    for (int j = 0; j < 4; ++j) { const int n = (lane >> 3) + 8 * j;
        const int src = perm ? (((n & 7) < 4) ? (4 * (n >> 3) + (n & 7)) : (16 + 4 * (n >> 3) + ((n & 7) - 4))) : n;
        const LAS float* s = scr + (8 * c) * 33 + src;
        u32x4 o; o.x = pk2(s[0 * 33], s[1 * 33]); o.y = pk2(s[2 * 33], s[3 * 33]); o.z = pk2(s[4 * 33], s[5 * 33]); o.w = pk2(s[6 * 33], s[7 * 33]);
        *(u32x4*)(WT + (size_t)(row_off + n0 + n) * K + k0 + 8 * c) = o; }
    asm volatile("s_waitcnt lgkmcnt(0)" ::: "memory");
}

__device__ __forceinline__ void sincos_d(double a, float& sn, float& cs) {
    const double kq = __builtin_rint(a * 0.63661977236758134308);
    double s = __builtin_fma(-kq, 1.57079632679489655800e+00, a); s = __builtin_fma(-kq, 6.12323399573676603587e-17, s);
    const int qi = ((int)kq) & 3;
    const double z = s * s;
    const double ps = s + s * z * (-1.0 / 6 + z * (1.0 / 120 + z * (-1.0 / 5040 + z * (1.0 / 362880 + z * (-1.0 / 39916800)))));
    const double pc = 1.0 + z * (-0.5 + z * (1.0 / 24 + z * (-1.0 / 720 + z * (1.0 / 40320 + z * (-1.0 / 3628800 + z * (1.0 / 479001600))))));
    const double sv = (qi == 0) ? ps : (qi == 1) ? pc : (qi == 2) ? -ps : -pc;
    const double cv = (qi == 0) ? pc : (qi == 1) ? -ps : (qi == 2) ? -pc : ps;
    sn = (float)sv; cs = (float)cv;
}

struct Args { const float* in[11]; float* out; unsigned char* ws; int ph_lo, ph_hi; };
constexpr int LDS_BYTES = 135168;

__global__ void __launch_bounds__(512) mega_fwd(Args args) {
    extern __shared__ __attribute__((aligned(16))) unsigned char lds_raw[];
    LAS unsigned char* lds = (LAS unsigned char*)lds_raw;
    cg::grid_group grid = cg::this_grid();

    if (args.ph_lo == 0) {
        int tid_ = threadIdx.x; asm volatile("" : "+v"(tid_));
        const int tid = tid_, lane = tid & 63, wave = __builtin_amdgcn_readfirstlane(tid >> 6);
        const int G = gridDim.x, bid = blockIdx.x, gw = bid * 8 + wave, NGW = G * 8;
        unsigned char* ws = args.ws;
        bf16_t* WinT = (bf16_t*)(ws + WS_WIN); bf16_t* WoT = (bf16_t*)(ws + WS_WO); bf16_t* PinT = (bf16_t*)(ws + WS_PIN);
        bf16_t* WgT = (bf16_t*)(ws + WS_WG); bf16_t* PoT = (bf16_t*)(ws + WS_PO); float* CS = (float*)(ws + WS_CS);
                LAS float* scr = (LAS float*)(lds + wave * 16384);
                constexpr int I_IN = 16 * 160, I_WO = 32 * 32, I_PIN = 16 * 128, I_WG = 8 * 16, I_PO = 32 * 32;
                constexpr int NITEMS = I_IN + I_WO + I_PIN + 4 * I_WG + I_PO;
                for (int it = gw; it < NITEMS; it += NGW) {
                    int r = it;
                    if (r < I_IN) { p0_transpose_item(args.in[4], 1024, 5120, WinT, 0, scr, r, lane, 1); continue; } r -= I_IN;
                    if (r < I_WO) { p0_transpose_item(args.in[6], 2048, 1024, WoT, 0, scr, r, lane, 0); continue; } r -= I_WO;
                    if (r < I_PIN) { p0_transpose_item(args.in[7], 1024, 4096, PinT, 0, scr, r, lane, 0); continue; } r -= I_PIN;
                    if (r < 4 * I_WG) { const int g = r / I_WG; p0_transpose_item(args.in[8] + (size_t)g * 512 * 512, 512, 512, WgT, g * 512, scr, r % I_WG, lane, 0); continue; } r -= 4 * I_WG;
                    p0_transpose_item(args.in[10], 2048, 1024, PoT, 0, scr, r, lane, 0);
                }
                for (int i = bid * 512 + tid; i < 16384 * 16; i += G * 512) {
                    const int pos = i >> 4, f = i & 15;
                    const float invf = (float)exp(-(double)f * (1.0 / 16.0) * 13.122363377404328);
                    const float ang = (float)pos * invf;
                    float sn, cs; sincos_d((double)ang, sn, cs);
                    CS[pos * 32 + f] = cs; CS[pos * 32 + 16 + f] = sn;
                }
            }
    for (int ph = args.ph_lo; ph < args.ph_hi; ++ph) {
        int tid_ = threadIdx.x; asm volatile("" : "+v"(tid_));
        const int tid = tid_, lane = tid & 63, wave = __builtin_amdgcn_readfirstlane(tid >> 6);
        const int G = gridDim.x, bid = blockIdx.x;
        const int gw = bid * 8 + wave, NGW = G * 8;
        unsigned char* ws = args.ws; asm volatile("" : "+s"(ws));
    bf16_t* WinT = (bf16_t*)(ws + WS_WIN); bf16_t* WoT = (bf16_t*)(ws + WS_WO); bf16_t* PinT = (bf16_t*)(ws + WS_PIN);
    bf16_t* WgT = (bf16_t*)(ws + WS_WG); bf16_t* PoT = (bf16_t*)(ws + WS_PO);
    float* CS = (float*)(ws + WS_CS); float* SS0 = (float*)(ws + WS_SS0); float* SS1 = (float*)(ws + WS_SS1);
    bf16_t* XN = (bf16_t*)(ws + WS_XN); bf16_t* BIG = (bf16_t*)(ws + WS_BIG); bf16_t* POOL = (bf16_t*)(ws + WS_POOL); bf16_t* OUTB = (bf16_t*)(ws + WS_OUT);
    const float* npre = args.in[2]; const float* npost = args.in[3];
        const int half = ph / 10, k = ph % 10;
        const float* xin = args.in[half];
        float* yout = args.out + (size_t)half * MH * DM;
        const int S = half == 0 ? 16384 : 2048;
        if (k == 0) {
            for (int row = gw; row < MH; row += NGW) {
                const f32x4* xr = (const f32x4*)(xin + (size_t)row * DM) + lane;
                f32x4 v[4]; float s = 0.f;
#pragma unroll
                for (int j = 0; j < 4; ++j) { v[j] = xr[64 * j]; s += (v[j].x * v[j].x + v[j].y * v[j].y) + (v[j].z * v[j].z + v[j].w * v[j].w); }
                const float rstd = 1.0f / sqrtf(wave_sum(s) * (1.0f / DM) + NORM_EPS);
                u32x2* o8 = (u32x2*)(XN + (size_t)row * DM) + lane;
#pragma unroll
                for (int j = 0; j < 4; ++j) { const f32x4 gg = *((const f32x4*)npre + lane + 64 * j);
                    u32x2 w; w.x = pk2(v[j].x * rstd * gg.x, v[j].y * rstd * gg.y); w.y = pk2(v[j].z * rstd * gg.z, v[j].w * rstd * gg.w); o8[64 * j] = w; }
            }
        } else if (k == 1 || k == 3 || k == 5 || k == 7 || k == 8) {
            pg8::Gemm g; pg8::Order O; pg8::Epi E;
            O.G = G; O.c = bid; O.grouped = 0;
            E.cs = CS; E.smask = S - 1; E.ss = SS0; E.scale = args.in[9];
            if (k == 1) { g.A = XN; g.lda = 1024; g.Bt = WinT; g.K = 1024; O.nM = MH / 256; O.nN = NQKVG / 256; E.mode = 0; E.O = BIG; E.ldc = NQKVG; }
            else if (k == 3) { g.A = BIG; g.lda = NQKVG; g.Bt = WoT; g.K = 2048; O.nM = MH / 256; O.nN = 4; E.mode = 2; E.O = OUTB; E.ldc = 1024; E.ss = SS0; }
            else if (k == 5) { g.A = XN; g.lda = 1024; g.Bt = PinT; g.K = 1024; O.nM = MH / 256; O.nN = NUG / 256; E.mode = 1; E.O = BIG; E.ldc = NUG; }
            else if (k == 7) { g.A = POOL; g.lda = 512; g.Bt = WgT; g.K = 512; O.nM = 512; O.nN = 2; O.grouped = 1; E.mode = 3; E.O = BIG; E.ldc = NUG; }
            else { g.A = BIG; g.lda = NUG; g.Bt = PoT; g.K = 2048; O.nM = MH / 256; O.nN = 4; E.mode = 2; E.O = OUTB; E.ldc = 1024; E.ss = SS1; }
            O.nwg = O.nM * O.nN;
            pg8::gemm_phase(lds, g, O, E);
        } else if (k == 2) {
            attn_phase(lds, BIG, args.in[5], S, G, bid);
        } else if (k == 4 || k == 9) {
            const float* ssp = (k == 4) ? SS0 : SS1;
            const float* base = (k == 4) ? xin : yout;
            const float* gpost = npost + ((k == 4) ? 0 : DM);
            for (int row = gw; row < MH; row += NGW) {
                float sp = (lane < 16) ? ssp[(size_t)row * 16 + lane] : 0.f;
                sp += __shfl_xor(sp, 1); sp += __shfl_xor(sp, 2); sp += __shfl_xor(sp, 4); sp += __shfl_xor(sp, 8);
                const float rs = 1.0f / sqrtf(__shfl(sp, 0) * (1.0f / DM) + NORM_EPS);
                const f32x4* xr = (const f32x4*)(base + (size_t)row * DM) + lane;
                const u32x2* orow = (const u32x2*)(OUTB + (size_t)row * DM) + lane;
                f32x4* yr = (f32x4*)(yout + (size_t)row * DM) + lane;
                f32x4 v[4]; float s = 0.f;
#pragma unroll
                for (int j = 0; j < 4; ++j) {
                    const f32x4 xv = xr[64 * j]; const u32x2 ow = orow[64 * j]; const f32x4 gg = *((const f32x4*)gpost + lane + 64 * j);
                    v[j].x = xv.x + bf_lo(ow.x) * rs * gg.x; v[j].y = xv.y + bf_hi(ow.x) * rs * gg.y; v[j].z = xv.z + bf_lo(ow.y) * rs * gg.z; v[j].w = xv.w + bf_hi(ow.y) * rs * gg.w;
                    s += (v[j].x * v[j].x + v[j].y * v[j].y) + (v[j].z * v[j].z + v[j].w * v[j].w);
                }
#pragma unroll
                for (int j = 0; j < 4; ++j) yr[64 * j] = v[j];
                if (k == 4) {
                    const float rstd = 1.0f / sqrtf(wave_sum(s) * (1.0f / DM) + NORM_EPS);
                    u32x2* o8 = (u32x2*)(XN + (size_t)row * DM) + lane;
#pragma unroll
                    for (int j = 0; j < 4; ++j) { const f32x4 gg = *((const f32x4*)(npre + DM) + lane + 64 * j);
                        u32x2 w; w.x = pk2(v[j].x * rstd * gg.x, v[j].y * rstd * gg.y); w.y = pk2(v[j].z * rstd * gg.z, v[j].w * rstd * gg.w); o8[64 * j] = w; }
                }
            }
        } else if (k == 6) {
            const int cc = tid & 255, tsub = tid >> 8, g = cc >> 6, hw = 1 << g;
            for (int blkI = bid; blkI < MH / 64; blkI += G) {
                const int t0 = blkI * 64 + tsub * 32, seq0 = t0 & ~(S - 1), seq1 = seq0 + S;
                const bf16_t* ub = BIG + cc * 8;
                float sum[8];
#pragma unroll
                for (int e = 0; e < 8; ++e) sum[e] = 0.f;
                { const int lo = max(t0 - hw, seq0), hi2 = min(t0 + hw - 1, seq1 - 1);
                  for (int j = lo; j <= hi2; ++j) { const u32x4 w = *(const u32x4*)(ub + (size_t)j * NUG);
                      sum[0] += bf_lo(w.x); sum[1] += bf_hi(w.x); sum[2] += bf_lo(w.y); sum[3] += bf_hi(w.y); sum[4] += bf_lo(w.z); sum[5] += bf_hi(w.z); sum[6] += bf_lo(w.w); sum[7] += bf_hi(w.w); } }
                bf16_t* pb = POOL + ((size_t)g * MH) * 512 + (cc & 63) * 8;
                for (int t = t0; t < t0 + 32; ++t) {
                    const int lo = max(t - hw, seq0), hi2 = min(t + hw - 1, seq1 - 1);
                    const float rc = 1.0f / (float)(hi2 - lo + 1);
                    const u32x4 w = *(const u32x4*)(ub + (size_t)t * NUG);
                    u32x4 o;
                    o.x = cvt_pk_bf16(sum[0] * rc - bf_lo(w.x), sum[1] * rc - bf_hi(w.x)); o.y = cvt_pk_bf16(sum[2] * rc - bf_lo(w.y), sum[3] * rc - bf_hi(w.y));
                    o.z = cvt_pk_bf16(sum[4] * rc - bf_lo(w.z), sum[5] * rc - bf_hi(w.z)); o.w = cvt_pk_bf16(sum[6] * rc - bf_lo(w.w), sum[7] * rc - bf_hi(w.w));
                    *(u32x4*)(pb + (size_t)t * 512) = o;
                    if (t + hw <= seq1 - 1) { const u32x4 a = *(const u32x4*)(ub + (size_t)(t + hw) * NUG);
                        sum[0] += bf_lo(a.x); sum[1] += bf_hi(a.x); sum[2] += bf_lo(a.y); sum[3] += bf_hi(a.y); sum[4] += bf_lo(a.z); sum[5] += bf_hi(a.z); sum[6] += bf_lo(a.w); sum[7] += bf_hi(a.w); }
                    if (t - hw >= seq0) { const u32x4 a = *(const u32x4*)(ub + (size_t)(t - hw) * NUG);
                        sum[0] -= bf_lo(a.x); sum[1] -= bf_hi(a.x); sum[2] -= bf_lo(a.y); sum[3] -= bf_hi(a.y); sum[4] -= bf_lo(a.z); sum[5] -= bf_hi(a.z); sum[6] -= bf_lo(a.w); sum[7] -= bf_hi(a.w); }
                }
            }
        }
        if (ph + 1 < args.ph_hi) grid.sync();
    }
}

extern "C" void kernel_launch(void* const* d_in, const int* in_sizes, int n_in, void* d_out, int out_size, void* d_ws, size_t ws_size, hipStream_t stream) {
    static int grid = 0;
    if (grid == 0) {
        if (n_in != 11 || ws_size < WS_END) { fprintf(stderr, "kernel_launch: unexpected n_in %d / ws_size %zu\n", n_in, ws_size); grid = -1; return; }
        int dev = 0, cus = 0, per_cu = 0;
        hipGetDevice(&dev);
        hipDeviceGetAttribute(&cus, hipDeviceAttributeMultiprocessorCount, dev);
        if (hipFuncSetAttribute((const void*)mega_fwd, hipFuncAttributeMaxDynamicSharedMemorySize, LDS_BYTES) != hipSuccess) { fprintf(stderr, "kernel_launch: hipFuncSetAttribute failed\n"); grid = -1; return; }
        if (hipOccupancyMaxActiveBlocksPerMultiprocessor(&per_cu, (const void*)mega_fwd, 512, LDS_BYTES) != hipSuccess || per_cu < 1) { fprintf(stderr, "kernel_launch: occupancy query gave %d\n", per_cu); per_cu = 1; }
        (void)hipGetLastError();
        grid = cus;
    }
    if (grid < 0) return;
    Args a{};
    for (int i = 0; i < 11; ++i) a.in[i] = (const float*)d_in[i];
    a.out = (float*)d_out; a.ws = (unsigned char*)d_ws; a.ph_lo = 0; a.ph_hi = 20;
    void* kargs[] = {&a};
    hipError_t e = hipLaunchCooperativeKernel((const void*)mega_fwd, dim3(grid), dim3(512), kargs, LDS_BYTES, stream);
    if (e != hipSuccess) fprintf(stderr, "cooperative launch failed: %s (grid %d)\n", hipGetErrorString(e), grid);
}
```

```cpp
#include <hip/hip_runtime.h>
#include <hip/hip_cooperative_groups.h>
#include <cstdio>
#include <cstdint>
namespace cg = cooperative_groups;

#define LAS __attribute__((address_space(3)))
typedef unsigned short bf16_t;
typedef short bf16x8 __attribute__((ext_vector_type(8)));
typedef short s16x4 __attribute__((ext_vector_type(4)));
typedef float f32x4 __attribute__((ext_vector_type(4)));
typedef float f32x16 __attribute__((ext_vector_type(16)));
typedef unsigned u32x4 __attribute__((ext_vector_type(4)));
typedef unsigned u32x2 __attribute__((ext_vector_type(2)));

constexpr int DM = 1024;
constexpr int MH = 32768;
constexpr int NQKVG = 5120;
constexpr int NUG = 4096;
constexpr float NORM_EPS = 1e-6f;
constexpr float LOG2E = 1.4426950408889634f;
constexpr float QSCALE = 1.4426950408889634f * 0.08838834764831845f;

constexpr size_t MiB = 1u << 20;
constexpr size_t WS_WIN = 1 * MiB;
constexpr size_t WS_WO = 11 * MiB;
constexpr size_t WS_PIN = 15 * MiB;
constexpr size_t WS_WG = 23 * MiB;
constexpr size_t WS_PO = 25 * MiB;
constexpr size_t WS_CS = 29 * MiB;
constexpr size_t WS_SS0 = 31 * MiB;
constexpr size_t WS_SS1 = 33 * MiB;
constexpr size_t WS_XN = 40 * MiB;
constexpr size_t WS_BIG = 104 * MiB;
constexpr size_t WS_POOL = 360 * MiB;
constexpr size_t WS_OUT = 424 * MiB;
constexpr size_t WS_END = 488 * MiB;

namespace pg8 {
constexpr int BM = 256, BK = 64, HALF = 128, HTB = HALF * BK * 2, STAGE_BYTES = 8 * HTB, NXCD = 8, WGM = 8;
__device__ __forceinline__ int lds_byte(int r, int c) { const int st = (r >> 4) * 2 + (c >> 5), rr = r & 15, cc = c & 31, ob = rr * 64 + cc * 2; return st * 1024 + (ob ^ (((ob >> 9) & 1) << 5)); }
__device__ __forceinline__ void stage_rc(int b, int& R, int& C) { const int st = b / 1024, sb = b % 1024, swz = sb ^ (((sb >> 9) & 1) << 5); R = (st >> 1) * 16 + swz / 64; C = (st & 1) * 32 + (swz % 64) / 2; }
__device__ __forceinline__ int perm32(int rho) { const int n = rho >> 4, i = rho & 15; return 8 * (i >> 2) + 4 * n + (i & 3); }

struct Unit { int pm, pn; };
struct Gemm { const bf16_t* A; const bf16_t* Bt; int lda, K; };

struct Order {
    int nM, nN, nwg, G, c, grouped;
    __device__ __forceinline__ bool next(int i, Unit& u) const {
        const long L = (long)i * G + c; if (L >= nwg) return false;
        if (grouped) { const int l = (int)L, g = l >> 8, rem = l & 255; u.pm = g * 128 + (rem & 127); u.pn = g * 2 + (rem >> 7); return true; }
        int wgid = (int)L; { const int q = nwg / NXCD, r = nwg % NXCD, xcd = wgid % NXCD, off = wgid / NXCD; wgid = (xcd < r ? xcd * (q + 1) : r * (q + 1) + (xcd - r) * q) + off; }
        const int nig = WGM * nN, gid = wgid / nig, fm = gid * WGM, gsz = (nM - fm) < WGM ? (nM - fm) : WGM;
        u.pm = fm + ((wgid % nig) % gsz); u.pn = (wgid % nig) / gsz; return true;
    }
};

__device__ __forceinline__ unsigned cvt_pk_bf16(float lo, float hi) { unsigned r; asm volatile("v_cvt_pk_bf16_f32 %0, %1, %2" : "=v"(r) : "v"(lo), "v"(hi)); return r; }
__device__ __forceinline__ float bf_lo(unsigned w) { return __uint_as_float(w << 16); }
__device__ __forceinline__ float bf_hi(unsigned w) { return __uint_as_float(w & 0xffff0000u); }
__device__ __forceinline__ float silu_f(float g) { return g * __builtin_amdgcn_rcpf(1.0f + __builtin_amdgcn_exp2f(-g * LOG2E)); }

struct Epi {
    int mode;
    bf16_t* O; int ldc;
    const float* cs; int smask;
    float* ss;
    const float* scale;
    __device__ __forceinline__ void operator()(const f32x4 (&acc)[2][2][4][2], const Unit& u, int wr, int wc, int fr, int fq) const {
        int pm = u.pm; if (mode == 3) pm &= 127;
        const int row0 = pm * BM + wr * 64 + fr, col0 = u.pn * BM + wc * 32 + 8 * fq;
        if (mode == 0) {
            const int kind = u.pn < 8 ? 0 : (u.pn < 10 ? 1 : 2);
            const float sc = kind == 0 ? QSCALE : 1.0f;
            const bool rope = (kind < 2) && (wc == 0);
#pragma unroll
            for (int ai = 0; ai < 2; ++ai)
#pragma unroll
                for (int m = 0; m < 4; ++m) {
                    const int row = row0 + ai * HALF + m * 16;
                    f32x4 c4 = (f32x4){1.f, 1.f, 1.f, 1.f}, s4 = (f32x4){0.f, 0.f, 0.f, 0.f};
                    if (rope) { const float* t = cs + (size_t)(row & smask) * 32 + 4 * fq; c4 = *(const f32x4*)t; s4 = *(const f32x4*)(t + 16); }
                    bf16_t* rowp = O + (size_t)row * ldc + col0;
#pragma unroll
                    for (int bj = 0; bj < 2; ++bj) {
                        f32x4 v0 = acc[ai][bj][m][0], v1 = acc[ai][bj][m][1];
                        if (rope) { const f32x4 n0 = v0 * c4 - v1 * s4, n1 = v1 * c4 + v0 * s4; v0 = n0; v1 = n1; }
                        v0 = v0 * sc; v1 = v1 * sc;
                        u32x4 w; w.x = cvt_pk_bf16(v0[0], v0[1]); w.y = cvt_pk_bf16(v0[2], v0[3]); w.z = cvt_pk_bf16(v1[0], v1[1]); w.w = cvt_pk_bf16(v1[2], v1[3]);
                        *(u32x4*)(rowp + bj * HALF) = w;
                    }
                }
        } else if (mode == 1) {
#pragma unroll
            for (int ai = 0; ai < 2; ++ai)
#pragma unroll
                for (int m = 0; m < 4; ++m) {
                    bf16_t* rowp = O + (size_t)(row0 + ai * HALF + m * 16) * ldc + col0;
#pragma unroll
                    for (int bj = 0; bj < 2; ++bj) {
                        const f32x4 v0 = acc[ai][bj][m][0], v1 = acc[ai][bj][m][1];
                        u32x4 w; w.x = cvt_pk_bf16(v0[0], v0[1]); w.y = cvt_pk_bf16(v0[2], v0[3]); w.z = cvt_pk_bf16(v1[0], v1[1]); w.w = cvt_pk_bf16(v1[2], v1[3]);
                        *(u32x4*)(rowp + bj * HALF) = w;
                    }
                }
        } else if (mode == 2) {
#pragma unroll
            for (int ai = 0; ai < 2; ++ai)
#pragma unroll
                for (int m = 0; m < 4; ++m) {
                    const int row = row0 + ai * HALF + m * 16;
                    bf16_t* rowp = O + (size_t)row * ldc + col0;
                    float s = 0.f;
#pragma unroll
                    for (int bj = 0; bj < 2; ++bj) {
                        const f32x4 v0 = acc[ai][bj][m][0], v1 = acc[ai][bj][m][1];
                        s += (v0[0] * v0[0] + v0[1] * v0[1]) + (v0[2] * v0[2] + v0[3] * v0[3]) + (v1[0] * v1[0] + v1[1] * v1[1]) + (v1[2] * v1[2] + v1[3] * v1[3]);
                        u32x4 w; w.x = cvt_pk_bf16(v0[0], v0[1]); w.y = cvt_pk_bf16(v0[2], v0[3]); w.z = cvt_pk_bf16(v1[0], v1[1]); w.w = cvt_pk_bf16(v1[2], v1[3]);
                        *(u32x4*)(rowp + bj * HALF) = w;
                    }
                    s += __shfl_xor(s, 16); s += __shfl_xor(s, 32);
                    if (fq == 0) ss[(size_t)row * 16 + u.pn * 4 + wc] = s;
                }
        } else {
            f32x4 sv[2][2];
#pragma unroll
            for (int bj = 0; bj < 2; ++bj) { sv[bj][0] = *(const f32x4*)(scale + col0 + bj * HALF); sv[bj][1] = *(const f32x4*)(scale + col0 + bj * HALF + 4); }
#pragma unroll
            for (int ai = 0; ai < 2; ++ai)
#pragma unroll
                for (int m = 0; m < 4; ++m) {
                    bf16_t* rowp = O + (size_t)(row0 + ai * HALF + m * 16) * ldc + col0;
#pragma unroll
                    for (int bj = 0; bj < 2; ++bj) {
                        const u32x4 gw = *(const u32x4*)(rowp + 2048 + bj * HALF);
                        f32x4 v0 = acc[ai][bj][m][0] * sv[bj][0], v1 = acc[ai][bj][m][1] * sv[bj][1];
                        v0[0] *= silu_f(bf_lo(gw.x)); v0[1] *= silu_f(bf_hi(gw.x)); v0[2] *= silu_f(bf_lo(gw.y)); v0[3] *= silu_f(bf_hi(gw.y));
                        v1[0] *= silu_f(bf_lo(gw.z)); v1[1] *= silu_f(bf_hi(gw.z)); v1[2] *= silu_f(bf_lo(gw.w)); v1[3] *= silu_f(bf_hi(gw.w));
                        u32x4 w; w.x = cvt_pk_bf16(v0[0], v0[1]); w.y = cvt_pk_bf16(v0[2], v0[3]); w.z = cvt_pk_bf16(v1[0], v1[1]); w.w = cvt_pk_bf16(v1[2], v1[3]);
                        *(u32x4*)(rowp + bj * HALF) = w;
                    }
                }
        }
    }
};

__device__ __forceinline__ void gemm_phase(LAS unsigned char* lds, const Gemm g, const Order& S, const Epi& E) {
    int tid_ = threadIdx.x; asm volatile("" : "+v"(tid_));
    const int tid = tid_, wid = __builtin_amdgcn_readfirstlane(tid >> 6), lane = tid & 63, wr = wid >> 2, wc = wid & 3, fr = lane & 15, fq = lane >> 4;
    const int K = g.K, nt = K / BK, lda = g.lda;
    unsigned voffA[2], voffB[2];
#pragma unroll
    for (int i = 0; i < 2; ++i) { int R, C; stage_rc(tid * 16 + i * 8192, R, C); const int Rb = (R & ~31) + perm32(R & 31);
        voffA[i] = (unsigned)(R * lda + C) * 2u; voffB[i] = (unsigned)(Rb * K + C) * 2u; }
    const size_t kstep = (size_t)(BK * 2);
    const size_t hstepA = (size_t)HALF * lda * 2, hstepB = (size_t)HALF * K * 2;
    const size_t tstepA = 2 * hstepA, tstepB = 2 * hstepB;
    const unsigned ldsw = (unsigned)wid * 1024u;
    const int aoff = lds_byte(wr * 64 + fr, fq * 8), boff = lds_byte(wc * 32 + fr, fq * 8);
#define PG8_SA(b, h) (((b) * 2 + (h)) * HTB)
#define PG8_SB(b, h) ((4 + (b) * 2 + (h)) * HTB)
#define PG8_STAGE(bufoff, gbase, voff) do { _Pragma("unroll") for (int _i = 0; _i < 2; ++_i) \
        __builtin_amdgcn_global_load_lds((const unsigned*)((const char*)(gbase) + (voff)[_i]), (LAS unsigned*)(lds + (bufoff) + ldsw + _i * 8192), 16, 0, 0); } while (0)
#define PG8_LDA(dst, b, h) do { _Pragma("unroll") for (int m = 0; m < 4; ++m) _Pragma("unroll") for (int k = 0; k < 2; ++k) dst[m][k] = *(const LAS bf16x8*)(lds + PG8_SA(b, h) + aoff + m * 2048 + k * 1024); } while (0)
#define PG8_LDB(dst, b, h) do { _Pragma("unroll") for (int n = 0; n < 2; ++n) _Pragma("unroll") for (int k = 0; k < 2; ++k) dst[n][k] = *(const LAS bf16x8*)(lds + PG8_SB(b, h) + boff + n * 2048 + k * 1024); } while (0)
#define PG8_MMA(ai, bj, At, Bt) do { __builtin_amdgcn_s_setprio(1); _Pragma("unroll") for (int m = 0; m < 4; ++m) _Pragma("unroll") for (int n = 0; n < 2; ++n) _Pragma("unroll") for (int k = 0; k < 2; ++k) \
        acc[ai][bj][m][n] = __builtin_amdgcn_mfma_f32_16x16x32_bf16(Bt[n][k], At[m][k], acc[ai][bj][m][n], 0, 0, 0); __builtin_amdgcn_s_setprio(0); } while (0)
#define PG8_WAIT_V(n) asm volatile("s_waitcnt vmcnt(" #n ")" ::: "memory")
#define PG8_WAIT_L(n) asm volatile("s_waitcnt lgkmcnt(" #n ")" ::: "memory")
#define PG8_BAR __builtin_amdgcn_s_barrier()
#define PG8_SCHED __builtin_amdgcn_sched_barrier(0)
    Unit cur, nxt; int ui = 0;
    if (!S.next(0, cur)) return;
    f32x4 acc[2][2][4][2];
#pragma unroll
    for (int a = 0; a < 2; ++a)
#pragma unroll
        for (int b = 0; b < 2; ++b)
#pragma unroll
            for (int m = 0; m < 4; ++m)
#pragma unroll
                for (int n = 0; n < 2; ++n) acc[a][b][m][n] = (f32x4){0.f, 0.f, 0.f, 0.f};
    bf16x8 At[4][2], B0[2][2], B1[2][2];
    const char* cA = (const char*)g.A + (size_t)cur.pm * tstepA; const char* cB = (const char*)g.Bt + (size_t)cur.pn * tstepB;
    PG8_STAGE(PG8_SB(0, 0), cB, voffB); PG8_STAGE(PG8_SB(0, 1), cB + hstepB, voffB); PG8_STAGE(PG8_SA(0, 0), cA, voffA); PG8_STAGE(PG8_SA(0, 1), cA + hstepA, voffA);
    if (wr == 1) PG8_BAR;
    PG8_WAIT_V(2); PG8_BAR;
    PG8_STAGE(PG8_SB(1, 0), cB + kstep, voffB); PG8_STAGE(PG8_SA(1, 0), cA + kstep, voffA); PG8_STAGE(PG8_SB(1, 1), cB + hstepB + kstep, voffB);
    PG8_WAIT_V(6); PG8_BAR;
    for (;;) {
        const bool has_next = S.next(ui + 1, nxt);
        const char* nA = has_next ? (const char*)g.A + (size_t)nxt.pm * tstepA : cA; const char* nB = has_next ? (const char*)g.Bt + (size_t)nxt.pn * tstepB : cB;
        for (int t = 0; t < nt; t += 2) {
            const bool last = (t == nt - 2);
            const char* a1 = cA + (size_t)(t + 1) * kstep;
            const char* a2 = last ? nA : cA + (size_t)(t + 2) * kstep; const char* b2 = last ? nB : cB + (size_t)(t + 2) * kstep;
            const char* a3 = a2 + kstep; const char* b3 = b2 + kstep;
            PG8_LDB(B0, 0, 0); PG8_LDB(B1, 0, 1); PG8_SCHED; PG8_LDA(At, 0, 0); PG8_STAGE(PG8_SA(1, 1), a1 + hstepA, voffA);
            PG8_WAIT_V(8); PG8_WAIT_L(0); PG8_BAR; PG8_MMA(0, 0, At, B0); PG8_MMA(0, 1, At, B1); PG8_BAR; PG8_SCHED;
            PG8_LDA(At, 0, 1); PG8_STAGE(PG8_SB(0, 0), b2, voffB); PG8_STAGE(PG8_SB(0, 1), b2 + hstepB, voffB); PG8_STAGE(PG8_SA(0, 0), a2, voffA);
            PG8_WAIT_V(8); PG8_WAIT_L(0); PG8_BAR; PG8_MMA(1, 0, At, B0); PG8_MMA(1, 1, At, B1); PG8_BAR; PG8_SCHED;
            PG8_LDB(B0, 1, 0); PG8_LDB(B1, 1, 1); PG8_SCHED; PG8_LDA(At, 1, 0); PG8_STAGE(PG8_SA(0, 1), a2 + hstepA, voffA);
            PG8_WAIT_V(8); PG8_WAIT_L(0); PG8_BAR; PG8_MMA(0, 0, At, B0); PG8_MMA(0, 1, At, B1); PG8_BAR; PG8_SCHED;
            PG8_LDA(At, 1, 1); PG8_STAGE(PG8_SB(1, 0), b3, voffB); PG8_STAGE(PG8_SB(1, 1), b3 + hstepB, voffB); PG8_STAGE(PG8_SA(1, 0), a3, voffA);
            PG8_WAIT_V(8); PG8_WAIT_L(0); PG8_BAR; PG8_MMA(1, 0, At, B0); PG8_MMA(1, 1, At, B1); PG8_BAR; PG8_SCHED;
        }
        if (wr == 0) PG8_BAR;
        E(acc, cur, wr, wc, fr, fq);
        if (!has_next) break;
#pragma unroll
        for (int a = 0; a < 2; ++a)
#pragma unroll
            for (int b = 0; b < 2; ++b)
#pragma unroll
                for (int m = 0; m < 4; ++m)
#pragma unroll
                    for (int n = 0; n < 2; ++n) acc[a][b][m][n] = (f32x4){0.f, 0.f, 0.f, 0.f};
        cur = nxt; cA = nA; cB = nB; ++ui;
        if (wr == 1) PG8_BAR;
    }
    PG8_WAIT_V(0);
    PG8_BAR;
#undef PG8_SA
#undef PG8_SB
#undef PG8_STAGE
#undef PG8_LDA
#undef PG8_LDB
#undef PG8_MMA
#undef PG8_WAIT_V
#undef PG8_WAIT_L
#undef PG8_BAR
#undef PG8_SCHED
}
}

using pg8::cvt_pk_bf16; using pg8::bf_lo; using pg8::bf_hi; using pg8::silu_f;

__device__ __forceinline__ unsigned off_b(unsigned row, unsigned ch) { return 256u * row + 16u * (ch ^ (((row & 3) << 2) | ((row >> 2) & 3))); }
__device__ __forceinline__ int crow(int r, int hi) { return (r & 3) + 8 * (r >> 2) + 4 * hi; }

__device__ __forceinline__ void attn_phase(LAS unsigned char* lds, bf16_t* QKVG, const float* sink, int S, int G, int bid) {
    int tid_ = threadIdx.x; asm volatile("" : "+v"(tid_));
    const int tid = tid_, lane = tid & 63, wid = __builtin_amdgcn_readfirstlane(tid >> 6);
    const int r32 = lane & 31, hi = lane >> 5, hloc = wid & 3, sb = wid >> 2;
    const int q4 = (lane & 15) >> 2, blk = (lane >> 4) & 1, p4 = lane & 3;
    const unsigned so0 = off_b(tid >> 4, tid & 15);
    for (int unit = bid; unit < (MH / 64) * 4; unit += G) {
        const int kvh = unit & 3, qc = unit >> 2, q0 = qc * 64;
        const int seq0 = q0 & ~(S - 1), seq1 = seq0 + S, k0 = q0 - 128;
        const int cfirst = (q0 - seq0 >= 128) ? 0 : ((q0 - seq0 >= 64) ? 1 : 2);
        const int clast = (seq1 - q0 - 64 >= 128) ? 4 : ((seq1 - q0 - 64 >= 64) ? 3 : 2);
        const int hq = kvh * 4 + hloc, qrow = q0 + sb * 32 + r32;
        bf16x8 qf[8];
        { const bf16_t* qp = QKVG + (size_t)qrow * NQKVG + hq * 128 + hi * 8;
#pragma unroll
          for (int s = 0; s < 8; ++s) qf[s] = *(const bf16x8*)(qp + 16 * s); }
        const bf16_t* kvp = QKVG + ((long)k0 + (tid >> 4)) * NQKVG + 2048 + kvh * 128 + (tid & 15) * 8;
        float m = sink[hq] * LOG2E, l = (hi == 0) ? 1.0f : 0.0f;
        f32x16 o[4];
#pragma unroll
        for (int c = 0; c < 4; ++c)
#pragma unroll
            for (int r = 0; r < 16; ++r) o[c][r] = 0.f;
        u32x4 rk0, rk1, rv0, rv1;
        { const bf16_t* p = kvp + (long)(64 * cfirst) * NQKVG;
          rk0 = *(const u32x4*)p; rk1 = *(const u32x4*)(p + 32 * NQKVG); rv0 = *(const u32x4*)(p + 512); rv1 = *(const u32x4*)(p + 32 * NQKVG + 512);
          const unsigned kb = (cfirst & 1) * 32768u;
          *(LAS u32x4*)(lds + kb + so0) = rk0; *(LAS u32x4*)(lds + kb + so0 + 8192) = rk1;
          *(LAS u32x4*)(lds + kb + 16384 + so0) = rv0; *(LAS u32x4*)(lds + kb + 16384 + so0 + 8192) = rv1; }
        __syncthreads();
        for (int c = cfirst; c <= clast; ++c) {
            const bool more = c < clast;
            if (more) { const bf16_t* p = kvp + (long)(64 * (c + 1)) * NQKVG;
                rk0 = *(const u32x4*)p; rk1 = *(const u32x4*)(p + 32 * NQKVG); rv0 = *(const u32x4*)(p + 512); rv1 = *(const u32x4*)(p + 32 * NQKVG + 512); }
            const unsigned kb = (c & 1) * 32768u, vb = kb + 16384u;
#pragma unroll
            for (int tt = 0; tt < 2; ++tt) {
                const int lt = 2 * c + tt - sb;
                if (lt >= 0 && lt <= 8) {
                    f32x16 st;
#pragma unroll
                    for (int r = 0; r < 16; ++r) st[r] = 0.f;
#pragma unroll
                    for (int s = 0; s < 8; ++s) {
                        const bf16x8 kf = *(const LAS bf16x8*)(lds + kb + off_b(tt * 32 + r32, 2 * s + hi));
                        st = __builtin_amdgcn_mfma_f32_32x32x16_bf16(kf, qf[s], st, 0, 0, 0);
                    }
                    if (lt == 0) {
#pragma unroll
                        for (int r = 0; r < 16; ++r) if (crow(r, hi) < r32) st[r] = -1e30f;
                    } else if (lt == 8) {
#pragma unroll
                        for (int r = 0; r < 16; ++r) if (crow(r, hi) > r32) st[r] = -1e30f;
                    }
                    float rm = st[0];
#pragma unroll
                    for (int r = 1; r < 16; ++r) rm = fmaxf(rm, st[r]);
                    rm = fmaxf(rm, __shfl_xor(rm, 32));
                    const float mn = fmaxf(m, rm), alpha = __builtin_amdgcn_exp2f(m - mn);
                    m = mn;
                    float ps = 0.f;
#pragma unroll
                    for (int r = 0; r < 16; ++r) { st[r] = __builtin_amdgcn_exp2f(st[r] - mn); ps += st[r]; }
                    l = l * alpha + ps;
#pragma unroll
                    for (int cc = 0; cc < 4; ++cc)
#pragma unroll
                        for (int r = 0; r < 16; ++r) o[cc][r] *= alpha;
                    bf16x8 pf[2];
#pragma unroll
                    for (int s = 0; s < 2; ++s) {
                        u32x4 w; w.x = cvt_pk_bf16(st[8 * s + 0], st[8 * s + 1]); w.y = cvt_pk_bf16(st[8 * s + 2], st[8 * s + 3]);
                        w.z = cvt_pk_bf16(st[8 * s + 4], st[8 * s + 5]); w.w = cvt_pk_bf16(st[8 * s + 6], st[8 * s + 7]);
                        pf[s] = __builtin_bit_cast(bf16x8, w);
                    }
#pragma unroll
                    for (int cc = 0; cc < 4; ++cc)
#pragma unroll
                        for (int s = 0; s < 2; ++s) {
                            const unsigned a0 = vb + off_b(tt * 32 + 16 * s + 4 * hi + q4, 4 * cc + 2 * blk + (p4 >> 1)) + 8 * (p4 & 1);
                            const unsigned a1 = vb + off_b(tt * 32 + 16 * s + 8 + 4 * hi + q4, 4 * cc + 2 * blk + (p4 >> 1)) + 8 * (p4 & 1);
                            const s16x4 lo = __builtin_amdgcn_ds_read_tr16_b64_v4i16((LAS s16x4*)(lds + a0));
                            const s16x4 hh = __builtin_amdgcn_ds_read_tr16_b64_v4i16((LAS s16x4*)(lds + a1));
                            const bf16x8 vf = (bf16x8){lo[0], lo[1], lo[2], lo[3], hh[0], hh[1], hh[2], hh[3]};
                            o[cc] = __builtin_amdgcn_mfma_f32_32x32x16_bf16(vf, pf[s], o[cc], 0, 0, 0);
                        }
                }
            }
            if (more) { const unsigned nb = ((c + 1) & 1) * 32768u;
                *(LAS u32x4*)(lds + nb + so0) = rk0; *(LAS u32x4*)(lds + nb + so0 + 8192) = rk1;
                *(LAS u32x4*)(lds + nb + 16384 + so0) = rv0; *(LAS u32x4*)(lds + nb + 16384 + so0 + 8192) = rv1; }
            __syncthreads();
        }
        l += __shfl_xor(l, 32);
        const float inv = 1.0f / l;
        bf16_t* orow = QKVG + (size_t)qrow * NQKVG + hq * 128;
#pragma unroll
        for (int cc = 0; cc < 4; ++cc)
#pragma unroll
            for (int g4 = 0; g4 < 4; ++g4) {
                const int d = 32 * cc + 8 * g4 + 4 * hi;
                const u32x2 gw = *(const u32x2*)(orow + 3072 + d);
                const float v0 = o[cc][4 * g4 + 0] * inv * silu_f(bf_lo(gw.x)), v1 = o[cc][4 * g4 + 1] * inv * silu_f(bf_hi(gw.x));
                const float v2 = o[cc][4 * g4 + 2] * inv * silu_f(bf_lo(gw.y)), v3 = o[cc][4 * g4 + 3] * inv * silu_f(bf_hi(gw.y));
                u32x2 w; w.x = cvt_pk_bf16(v0, v1); w.y = cvt_pk_bf16(v2, v3);
                *(u32x2*)(orow + d) = w;
            }
    }
}

__device__ __forceinline__ float wave_sum(float v) {
#pragma unroll
    for (int o = 1; o < 64; o <<= 1) v += __shfl_xor(v, o);
    return v;
}
__device__ __forceinline__ unsigned f2bf(float f) { unsigned u = __builtin_bit_cast(unsigned, f); return (u + 0x7fffu + ((u >> 16) & 1u)) >> 16; }
__device__ __forceinline__ unsigned pk2(float lo, float hi) { return f2bf(lo) | (f2bf(hi) << 16); }

__device__ __forceinline__ void p0_transpose_item(const float* W, int K, int N, bf16_t* WT, int row_off, LAS float* scr, int item, int lane, int rope) {
    const int nblk = N / 32, kb = item / nblk, nb = item % nblk, k0 = 64 * kb, n0 = 32 * nb;
#pragma unroll 8
    for (int i = 0; i < 32; ++i) { const int kk = 2 * i + (lane >> 5); scr[kk * 33 + (lane & 31)] = W[(size_t)(k0 + kk) * N + n0 + (lane & 31)]; }
    asm volatile("s_waitcnt lgkmcnt(0)" ::: "memory");
    const bool perm = rope && ((n0 & 127) == 0) && (n0 < 2560);
    const int c = lane & 7;
#pragma unroll
    for (int j = 0; j < 4; ++j) { const int n = (lane >> 3) + 8 * j;
        const int src = perm ? (((n & 7) < 4) ? (4 * (n >> 3) + (n & 7)) : (16 + 4 * (n >> 3) + ((n & 7) - 4))) : n;
        const LAS float* s = scr + (8 * c) * 33 + src;
        u32x4 o; o.x = pk2(s[0 * 33], s[1 * 33]); o.y = pk2(s[2 * 33], s[3 * 33]); o.z = pk2(s[4 * 33], s[5 * 33]); o.w = pk2(s[6 * 33], s[7 * 33]);
        *(u32x4*)(WT + (size_t)(row_off + n0 + n) * K + k0 + 8 * c) = o; }
    asm volatile("s_waitcnt lgkmcnt(0)" ::: "memory");
}

__device__ __forceinline__ void sincos_d(double a, float& sn, float& cs) {
    const double kq = __builtin_rint(a * 0.63661977236758134308);
    double s = __builtin_fma(-kq, 1.57079632679489655800e+00, a); s = __builtin_fma(-kq, 6.12323399573676603587e-17, s);
    const int qi = ((int)kq) & 3;
    const double z = s * s;
    const double ps = s + s * z * (-1.0 / 6 + z * (1.0 / 120 + z * (-1.0 / 5040 + z * (1.0 / 362880 + z * (-1.0 / 39916800)))));
    const double pc = 1.0 + z * (-0.5 + z * (1.0 / 24 + z * (-1.0 / 720 + z * (1.0 / 40320 + z * (-1.0 / 3628800 + z * (1.0 / 479001600))))));
    const double sv = (qi == 0) ? ps : (qi == 1) ? pc : (qi == 2) ? -ps : -pc;
    const double cv = (qi == 0) ? pc : (qi == 1) ? -ps : (qi == 2) ? -pc : ps;
    sn = (float)sv; cs = (float)cv;
}

#define XB_TMO      128
#define XB_XCNT(j)  (256  + 64 * (j))
#define XB_XSUB(j)  (1280 + 64 * (j))
#define XB_XGEN(j)  (2304 + 64 * (j))
#define XB_TOP      3328
#define XB_TOPGEN   3392
#define XCD_BAR_WORDS 3456
#define XB_SPIN_CAP (1u << 18)
__device__ __forceinline__ unsigned xb_ld(unsigned* p)              { return __hip_atomic_load(p, __ATOMIC_RELAXED, __HIP_MEMORY_SCOPE_AGENT); }
__device__ __forceinline__ unsigned xb_add(unsigned* p, unsigned v) { return __hip_atomic_fetch_add(p, v, __ATOMIC_RELAXED, __HIP_MEMORY_SCOPE_AGENT); }
__device__ __forceinline__ unsigned xb_xcc_id() { return (unsigned)__builtin_amdgcn_s_getreg((3 << 11) | 20) & 0xFu; }
#define XB_SPIN(cond, bar) do { unsigned _sp = 0; while (cond) { __builtin_amdgcn_s_sleep(1); \
    if ((++_sp & 255u) == 0u) { if (xb_ld(&(bar)[XB_TMO])) break; if (_sp > XB_SPIN_CAP) { atomicAdd(&(bar)[XB_TMO], 1u); break; } } } } while (0)
struct XcdBarrier { unsigned* bar; unsigned x; volatile LAS unsigned* st; };
__device__ __forceinline__ XcdBarrier xcd_barrier_post(unsigned* bar, volatile LAS unsigned* st) {
    XcdBarrier b; b.bar = bar; b.x = xb_xcc_id(); b.st = st;
    if (threadIdx.x == 0) (void)xb_add(&bar[XB_XCNT(b.x)], 1u);
    return b;
}
__device__ __forceinline__ void xcd_barrier_complete(unsigned* bar, unsigned x, unsigned& nloc, unsigned& nx) {
    const unsigned G = gridDim.x * gridDim.y * gridDim.z;
    unsigned sum, cnt, mine, sp = 0u;
    for (;;) {
        sum = 0u; cnt = 0u; mine = 0u;
#pragma unroll
        for (unsigned j = 0; j < 16; ++j) { const unsigned c = xb_ld(&bar[XB_XCNT(j)]); sum += c; cnt += (c > 0u) ? 1u : 0u; mine = (j == x) ? c : mine; }
        if (sum == G) break;
        __builtin_amdgcn_s_sleep(1);
        if ((++sp & 255u) == 0u) { if (xb_ld(&bar[XB_TMO])) break; if (sp > XB_SPIN_CAP) { atomicAdd(&bar[XB_TMO], 1u); break; } }
    }
    nloc = mine > 0u ? mine : 1u; nx = cnt > 0u ? cnt : 1u;
}
__device__ __forceinline__ void xcd_barrier(const XcdBarrier& b) {
    asm volatile("s_waitcnt vmcnt(0)" ::: "memory");
    __syncthreads();
    if (threadIdx.x == 0) {
        unsigned* bar = b.bar;
        __builtin_amdgcn_s_waitcnt(0);
        unsigned nloc = b.st[0], nx = b.st[1];
        if (nloc == 0u) { xcd_barrier_complete(bar, b.x, nloc, nx); b.st[0] = nloc; b.st[1] = nx; }
        const unsigned old = xb_add(&bar[XB_XSUB(b.x)], 1u);
        const unsigned gen = old / nloc;
        if (old + 1u == (gen + 1u) * nloc) {
            __builtin_amdgcn_fence(__ATOMIC_RELEASE, "agent");
            asm volatile("s_waitcnt vmcnt(0)" ::: "memory");
            const unsigned og = xb_add(&bar[XB_TOP], 1u);
            const unsigned tg = og / nx;
            if (og + 1u == (tg + 1u) * nx) xb_add(&bar[XB_TOPGEN], 1u);
            else XB_SPIN(xb_ld(&bar[XB_TOPGEN]) == tg, bar);
            __builtin_amdgcn_fence(__ATOMIC_ACQUIRE, "agent");
            xb_add(&bar[XB_XGEN(b.x)], 1u);
            asm volatile("s_waitcnt vmcnt(0)" ::: "memory");
        } else {
            XB_SPIN(xb_ld(&bar[XB_XGEN(b.x)]) == gen, bar);
            __builtin_amdgcn_fence(__ATOMIC_ACQUIRE, "agent");
            asm volatile("s_waitcnt vmcnt(0)" ::: "memory");
        }
    }
    __syncthreads();
}

struct Args { const float* in[11]; float* out; unsigned char* ws; int ph_lo, ph_hi; unsigned char seq[64]; };
constexpr int LDS_BYTES = 135168;

__global__ void __launch_bounds__(512) mega_fwd(Args args) {
    extern __shared__ __attribute__((aligned(16))) unsigned char lds_raw[];
    LAS unsigned char* lds = (LAS unsigned char*)lds_raw;
    cg::grid_group grid = cg::this_grid();
    volatile LAS unsigned* MISC = (volatile LAS unsigned*)(lds + 131072 + 256);
    if (threadIdx.x < 4) MISC[threadIdx.x] = 0u;
    __syncthreads();
    const XcdBarrier xbar = xcd_barrier_post((unsigned*)args.ws, MISC);

    if (args.ph_lo == 0) {
        int tid_ = threadIdx.x; asm volatile("" : "+v"(tid_));
        const int tid = tid_, lane = tid & 63, wave = __builtin_amdgcn_readfirstlane(tid >> 6);
        const int G = gridDim.x, bid = blockIdx.x, gw = bid * 8 + wave, NGW = G * 8;
        unsigned char* ws = args.ws;
        bf16_t* WinT = (bf16_t*)(ws + WS_WIN); bf16_t* WoT = (bf16_t*)(ws + WS_WO); bf16_t* PinT = (bf16_t*)(ws + WS_PIN);
        bf16_t* WgT = (bf16_t*)(ws + WS_WG); bf16_t* PoT = (bf16_t*)(ws + WS_PO); float* CS = (float*)(ws + WS_CS);
                LAS float* scr = (LAS float*)(lds + wave * 16384);
                constexpr int I_IN = 16 * 160, I_WO = 32 * 32, I_PIN = 16 * 128, I_WG = 8 * 16, I_PO = 32 * 32;
                constexpr int NITEMS = I_IN + I_WO + I_PIN + 4 * I_WG + I_PO;
                for (int it = gw; it < NITEMS; it += NGW) {
                    int r = it;
                    if (r < I_IN) { p0_transpose_item(args.in[4], 1024, 5120, WinT, 0, scr, r, lane, 1); continue; } r -= I_IN;
                    if (r < I_WO) { p0_transpose_item(args.in[6], 2048, 1024, WoT, 0, scr, r, lane, 0); continue; } r -= I_WO;
                    if (r < I_PIN) { p0_transpose_item(args.in[7], 1024, 4096, PinT, 0, scr, r, lane, 0); continue; } r -= I_PIN;
                    if (r < 4 * I_WG) { const int g = r / I_WG; p0_transpose_item(args.in[8] + (size_t)g * 512 * 512, 512, 512, WgT, g * 512, scr, r % I_WG, lane, 0); continue; } r -= 4 * I_WG;
                    p0_transpose_item(args.in[10], 2048, 1024, PoT, 0, scr, r, lane, 0);
                }
                for (int i = bid * 512 + tid; i < 16384 * 16; i += G * 512) {
                    const int pos = i >> 4, f = i & 15;
                    const float invf = (float)exp(-(double)f * (1.0 / 16.0) * 13.122363377404328);
                    const float ang = (float)pos * invf;
                    float sn, cs; sincos_d((double)ang, sn, cs);
                    CS[pos * 32 + f] = cs; CS[pos * 32 + 16 + f] = sn;
                }
            }
    for (int ph = args.ph_lo; ph < args.ph_hi; ++ph) {
        int tid_ = threadIdx.x; asm volatile("" : "+v"(tid_));
        const int tid = tid_, lane = tid & 63, wave = __builtin_amdgcn_readfirstlane(tid >> 6);
        const int G = gridDim.x, bid = blockIdx.x;
        const int gw = bid * 8 + wave, NGW = G * 8;
        unsigned char* ws = args.ws; asm volatile("" : "+s"(ws));
    bf16_t* WinT = (bf16_t*)(ws + WS_WIN); bf16_t* WoT = (bf16_t*)(ws + WS_WO); bf16_t* PinT = (bf16_t*)(ws + WS_PIN);
    bf16_t* WgT = (bf16_t*)(ws + WS_WG); bf16_t* PoT = (bf16_t*)(ws + WS_PO);
    float* CS = (float*)(ws + WS_CS); float* SS0 = (float*)(ws + WS_SS0); float* SS1 = (float*)(ws + WS_SS1);
    bf16_t* XN = (bf16_t*)(ws + WS_XN); bf16_t* BIG = (bf16_t*)(ws + WS_BIG); bf16_t* POOL = (bf16_t*)(ws + WS_POOL); bf16_t* OUTB = (bf16_t*)(ws + WS_OUT);
    const float* npre = args.in[2]; const float* npost = args.in[3];
        const int code = args.seq[ph], half = (code / 10) & 1, k = code == 255 ? 10 : code % 10;
        const float* xin = args.in[half];
        float* yout = args.out + (size_t)half * MH * DM;
        const int S = half == 0 ? 16384 : 2048;
        if (k == 0) {
            for (int row = gw; row < MH; row += NGW) {
                const f32x4* xr = (const f32x4*)(xin + (size_t)row * DM) + lane;
                f32x4 v[4]; float s = 0.f;
#pragma unroll
                for (int j = 0; j < 4; ++j) { v[j] = xr[64 * j]; s += (v[j].x * v[j].x + v[j].y * v[j].y) + (v[j].z * v[j].z + v[j].w * v[j].w); }
                const float rstd = 1.0f / sqrtf(wave_sum(s) * (1.0f / DM) + NORM_EPS);
                u32x2* o8 = (u32x2*)(XN + (size_t)row * DM) + lane;
#pragma unroll
                for (int j = 0; j < 4; ++j) { const f32x4 gg = *((const f32x4*)npre + lane + 64 * j);
                    u32x2 w; w.x = pk2(v[j].x * rstd * gg.x, v[j].y * rstd * gg.y); w.y = pk2(v[j].z * rstd * gg.z, v[j].w * rstd * gg.w); o8[64 * j] = w; }
            }
        } else if (k == 1 || k == 3 || k == 5 || k == 7 || k == 8) {
            pg8::Gemm g; pg8::Order O; pg8::Epi E;
            O.G = G; O.c = bid; O.grouped = 0;
            E.cs = CS; E.smask = S - 1; E.ss = SS0; E.scale = args.in[9];
            if (k == 1) { g.A = XN; g.lda = 1024; g.Bt = WinT; g.K = 1024; O.nM = MH / 256; O.nN = NQKVG / 256; E.mode = 0; E.O = BIG; E.ldc = NQKVG; }
            else if (k == 3) { g.A = BIG; g.lda = NQKVG; g.Bt = WoT; g.K = 2048; O.nM = MH / 256; O.nN = 4; E.mode = 2; E.O = OUTB; E.ldc = 1024; E.ss = SS0; }
            else if (k == 5) { g.A = XN; g.lda = 1024; g.Bt = PinT; g.K = 1024; O.nM = MH / 256; O.nN = NUG / 256; E.mode = 1; E.O = BIG; E.ldc = NUG; }
            else if (k == 7) { g.A = POOL; g.lda = 512; g.Bt = WgT; g.K = 512; O.nM = 512; O.nN = 2; O.grouped = 1; E.mode = 3; E.O = BIG; E.ldc = NUG; }
            else { g.A = BIG; g.lda = NUG; g.Bt = PoT; g.K = 2048; O.nM = MH / 256; O.nN = 4; E.mode = 2; E.O = OUTB; E.ldc = 1024; E.ss = SS1; }
            O.nwg = O.nM * O.nN;
            pg8::gemm_phase(lds, g, O, E);
        } else if (k == 2) {
            attn_phase(lds, BIG, args.in[5], S, G, bid);
        } else if (k == 4 || k == 9) {
            const float* ssp = (k == 4) ? SS0 : SS1;
            const float* base = (k == 4) ? xin : yout;
            const float* gpost = npost + ((k == 4) ? 0 : DM);
            for (int row = gw; row < MH; row += NGW) {
                float sp = (lane < 16) ? ssp[(size_t)row * 16 + lane] : 0.f;
                sp += __shfl_xor(sp, 1); sp += __shfl_xor(sp, 2); sp += __shfl_xor(sp, 4); sp += __shfl_xor(sp, 8);
                const float rs = 1.0f / sqrtf(__shfl(sp, 0) * (1.0f / DM) + NORM_EPS);
                const f32x4* xr = (const f32x4*)(base + (size_t)row * DM) + lane;
                const u32x2* orow = (const u32x2*)(OUTB + (size_t)row * DM) + lane;
                f32x4* yr = (f32x4*)(yout + (size_t)row * DM) + lane;
                f32x4 v[4]; float s = 0.f;
#pragma unroll
                for (int j = 0; j < 4; ++j) {
                    const f32x4 xv = xr[64 * j]; const u32x2 ow = orow[64 * j]; const f32x4 gg = *((const f32x4*)gpost + lane + 64 * j);
                    v[j].x = xv.x + bf_lo(ow.x) * rs * gg.x; v[j].y = xv.y + bf_hi(ow.x) * rs * gg.y; v[j].z = xv.z + bf_lo(ow.y) * rs * gg.z; v[j].w = xv.w + bf_hi(ow.y) * rs * gg.w;
                    s += (v[j].x * v[j].x + v[j].y * v[j].y) + (v[j].z * v[j].z + v[j].w * v[j].w);
                }
#pragma unroll
                for (int j = 0; j < 4; ++j) yr[64 * j] = v[j];
                if (k == 4) {
                    const float rstd = 1.0f / sqrtf(wave_sum(s) * (1.0f / DM) + NORM_EPS);
                    u32x2* o8 = (u32x2*)(XN + (size_t)row * DM) + lane;
#pragma unroll
                    for (int j = 0; j < 4; ++j) { const f32x4 gg = *((const f32x4*)(npre + DM) + lane + 64 * j);
                        u32x2 w; w.x = pk2(v[j].x * rstd * gg.x, v[j].y * rstd * gg.y); w.y = pk2(v[j].z * rstd * gg.z, v[j].w * rstd * gg.w); o8[64 * j] = w; }
                }
            }
        } else if (k == 6) {
            const int cc = tid & 255, tsub = tid >> 8, g = cc >> 6, hw = 1 << g;
            for (int blkI = bid; blkI < MH / 64; blkI += G) {
                const int t0 = blkI * 64 + tsub * 32, seq0 = t0 & ~(S - 1), seq1 = seq0 + S;
                const bf16_t* ub = BIG + cc * 8;
                float sum[8];
#pragma unroll
                for (int e = 0; e < 8; ++e) sum[e] = 0.f;
                { const int lo = max(t0 - hw, seq0), hi2 = min(t0 + hw - 1, seq1 - 1);
                  for (int j = lo; j <= hi2; ++j) { const u32x4 w = *(const u32x4*)(ub + (size_t)j * NUG);
                      sum[0] += bf_lo(w.x); sum[1] += bf_hi(w.x); sum[2] += bf_lo(w.y); sum[3] += bf_hi(w.y); sum[4] += bf_lo(w.z); sum[5] += bf_hi(w.z); sum[6] += bf_lo(w.w); sum[7] += bf_hi(w.w); } }
                bf16_t* pb = POOL + ((size_t)g * MH) * 512 + (cc & 63) * 8;
                for (int t = t0; t < t0 + 32; ++t) {
                    const int lo = max(t - hw, seq0), hi2 = min(t + hw - 1, seq1 - 1);
                    const float rc = 1.0f / (float)(hi2 - lo + 1);
                    const u32x4 w = *(const u32x4*)(ub + (size_t)t * NUG);
                    u32x4 o;
                    o.x = cvt_pk_bf16(sum[0] * rc - bf_lo(w.x), sum[1] * rc - bf_hi(w.x)); o.y = cvt_pk_bf16(sum[2] * rc - bf_lo(w.y), sum[3] * rc - bf_hi(w.y));
                    o.z = cvt_pk_bf16(sum[4] * rc - bf_lo(w.z), sum[5] * rc - bf_hi(w.z)); o.w = cvt_pk_bf16(sum[6] * rc - bf_lo(w.w), sum[7] * rc - bf_hi(w.w));
                    *(u32x4*)(pb + (size_t)t * 512) = o;
                    if (t + hw <= seq1 - 1) { const u32x4 a = *(const u32x4*)(ub + (size_t)(t + hw) * NUG);
                        sum[0] += bf_lo(a.x); sum[1] += bf_hi(a.x); sum[2] += bf_lo(a.y); sum[3] += bf_hi(a.y); sum[4] += bf_lo(a.z); sum[5] += bf_hi(a.z); sum[6] += bf_lo(a.w); sum[7] += bf_hi(a.w); }
                    if (t - hw >= seq0) { const u32x4 a = *(const u32x4*)(ub + (size_t)(t - hw) * NUG);
                        sum[0] -= bf_lo(a.x); sum[1] -= bf_hi(a.x); sum[2] -= bf_lo(a.y); sum[3] -= bf_hi(a.y); sum[4] -= bf_lo(a.z); sum[5] -= bf_hi(a.z); sum[6] -= bf_lo(a.w); sum[7] -= bf_hi(a.w); }
                }
            }
        }
        if (ph + 1 < args.ph_hi) { if (ph == args.ph_lo) grid.sync(); else xcd_barrier(xbar); }
    }
}

extern "C" void kernel_launch(void* const* d_in, const int* in_sizes, int n_in, void* d_out, int out_size, void* d_ws, size_t ws_size, hipStream_t stream) {
    static int grid = 0;
    if (grid == 0) {
        if (n_in != 11 || ws_size < WS_END) { fprintf(stderr, "kernel_launch: unexpected n_in %d / ws_size %zu\n", n_in, ws_size); grid = -1; return; }
        int dev = 0, cus = 0, per_cu = 0;
        hipGetDevice(&dev);
        hipDeviceGetAttribute(&cus, hipDeviceAttributeMultiprocessorCount, dev);
        if (hipFuncSetAttribute((const void*)mega_fwd, hipFuncAttributeMaxDynamicSharedMemorySize, LDS_BYTES) != hipSuccess) { fprintf(stderr, "kernel_launch: hipFuncSetAttribute failed\n"); grid = -1; return; }
        if (hipOccupancyMaxActiveBlocksPerMultiprocessor(&per_cu, (const void*)mega_fwd, 512, LDS_BYTES) != hipSuccess || per_cu < 1) { fprintf(stderr, "kernel_launch: occupancy query gave %d\n", per_cu); per_cu = 1; }
        (void)hipGetLastError();
        grid = cus;
    }
    if (grid < 0) return;
    if (hipMemsetAsync(d_ws, 0, 16384, stream) != hipSuccess) { fprintf(stderr, "kernel_launch: memset failed\n"); return; }
    Args a{};
    for (int i = 0; i < 11; ++i) a.in[i] = (const float*)d_in[i];
    a.out = (float*)d_out; a.ws = (unsigned char*)d_ws; a.ph_lo = 0;
    { int n = 0;
#ifndef REP_MASK
#define REP_MASK 0
#endif
#ifndef EXTRA_SYNCS
#define EXTRA_SYNCS 0
#endif
      for (int h = 0; h < 2; ++h) for (int k = 0; k < 10; ++k) { a.seq[n++] = (unsigned char)(h * 10 + k); if ((REP_MASK >> k) & 1) a.seq[n++] = (unsigned char)(h * 10 + k); }
      for (int i = 0; i < EXTRA_SYNCS; ++i) a.seq[n++] = 255;
      a.ph_hi = n; }
    void* kargs[] = {&a};
    hipError_t e = hipLaunchCooperativeKernel((const void*)mega_fwd, dim3(grid), dim3(512), kargs, LDS_BYTES, stream);
    if (e != hipSuccess) fprintf(stderr, "cooperative launch failed: %s (grid %d)\n", hipGetErrorString(e), grid);
}
```

```cpp
#include <hip/hip_runtime.h>
#include <hip/hip_cooperative_groups.h>
#include <cstdio>
#include <cstdint>
namespace cg = cooperative_groups;

#define LAS __attribute__((address_space(3)))
#define GAS __attribute__((address_space(1)))
typedef unsigned short bf16_t;
typedef short bf16x8 __attribute__((ext_vector_type(8)));
typedef short s16x4 __attribute__((ext_vector_type(4)));
typedef float f32x4 __attribute__((ext_vector_type(4)));
typedef float f32x16 __attribute__((ext_vector_type(16)));
typedef unsigned u32x4 __attribute__((ext_vector_type(4)));
typedef unsigned u32x2 __attribute__((ext_vector_type(2)));

constexpr int DM = 1024;
#ifndef MH_ROWS
#define MH_ROWS 16384
#endif
constexpr int MH = MH_ROWS;
constexpr int NPART = 65536 / MH;
constexpr int NQKVG = 5120;
constexpr int NUG = 4096;
constexpr float NORM_EPS = 1e-6f;
constexpr float LOG2E = 1.4426950408889634f;
constexpr float QSCALE = 1.4426950408889634f * 0.08838834764831845f;

constexpr size_t MiB = 1u << 20;
constexpr size_t WS_WIN = 1 * MiB;
constexpr size_t WS_WO = 11 * MiB;
constexpr size_t WS_PIN = 15 * MiB;
constexpr size_t WS_WG = 23 * MiB;
constexpr size_t WS_PO = 25 * MiB;
constexpr size_t WS_CS = 29 * MiB;
constexpr size_t WS_SS0 = 31 * MiB;
constexpr size_t WS_SS1 = 33 * MiB;
constexpr size_t WS_XN = 40 * MiB;
constexpr size_t WS_BIG = 104 * MiB;
constexpr size_t WS_POOL = 360 * MiB;
constexpr size_t WS_OUT = 424 * MiB;
constexpr size_t WS_END = 488 * MiB;

namespace pg8 {
constexpr int BM = 256, BK = 64, HALF = 128, HTB = HALF * BK * 2, STAGE_BYTES = 8 * HTB, NXCD = 8, WGM = 8;
__device__ __forceinline__ int lds_byte(int r, int c) { const int st = (r >> 4) * 2 + (c >> 5), rr = r & 15, cc = c & 31, ob = rr * 64 + cc * 2; return st * 1024 + (ob ^ (((ob >> 9) & 1) << 5)); }
__device__ __forceinline__ void stage_rc(int b, int& R, int& C) { const int st = b / 1024, sb = b % 1024, swz = sb ^ (((sb >> 9) & 1) << 5); R = (st >> 1) * 16 + swz / 64; C = (st & 1) * 32 + (swz % 64) / 2; }
__device__ __forceinline__ int perm32(int rho) { const int n = rho >> 4, i = rho & 15; return 8 * (i >> 2) + 4 * n + (i & 3); }

struct Unit { int pm, pn; };
struct Gemm { const bf16_t* A; const bf16_t* Bt; int lda, K; };

struct Order {
    int nM, nN, nwg, G, c, grouped;
    __device__ __forceinline__ bool next(int i, Unit& u) const {
        const long L = (long)i * G + c; if (L >= nwg) return false;
        if (grouped) { constexpr int NR = MH / 256; const int l = (int)L, g = l / (2 * NR), rem = l % (2 * NR); u.pm = g * NR + (rem % NR); u.pn = g * 2 + (rem / NR); return true; }
        int wgid = (int)L; { const int q = nwg / NXCD, r = nwg % NXCD, xcd = wgid % NXCD, off = wgid / NXCD; wgid = (xcd < r ? xcd * (q + 1) : r * (q + 1) + (xcd - r) * q) + off; }
        const int nig = WGM * nN, gid = wgid / nig, fm = gid * WGM, gsz = (nM - fm) < WGM ? (nM - fm) : WGM;
        u.pm = fm + ((wgid % nig) % gsz); u.pn = (wgid % nig) / gsz; return true;
    }
};

__device__ __forceinline__ unsigned cvt_pk_bf16(float lo, float hi) { unsigned r; asm volatile("v_cvt_pk_bf16_f32 %0, %1, %2" : "=v"(r) : "v"(lo), "v"(hi)); return r; }
__device__ __forceinline__ float bf_lo(unsigned w) { return __uint_as_float(w << 16); }
__device__ __forceinline__ float bf_hi(unsigned w) { return __uint_as_float(w & 0xffff0000u); }
__device__ __forceinline__ float silu_f(float g) { return g * __builtin_amdgcn_rcpf(1.0f + __builtin_amdgcn_exp2f(-g * LOG2E)); }

struct Epi {
    int mode;
    bf16_t* O; int ldc;
    const float* cs; int smask;
    float* ss;
    const float* scale;
    __device__ __forceinline__ void operator()(const f32x4 (&acc)[2][2][4][2], const Unit& u, int wr, int wc, int fr, int fq) const {
        int pm = u.pm; if (mode == 3) pm %= (MH / 256);
        const int row0 = pm * BM + wr * 64 + fr, col0 = u.pn * BM + wc * 32 + 8 * fq;
        if (mode == 0) {
            const int kind = u.pn < 8 ? 0 : (u.pn < 10 ? 1 : 2);
            const float sc = kind == 0 ? QSCALE : 1.0f;
            const bool rope = (kind < 2) && (wc == 0);
#pragma unroll
            for (int ai = 0; ai < 2; ++ai)
#pragma unroll
                for (int m = 0; m < 4; ++m) {
                    const int row = row0 + ai * HALF + m * 16;
                    f32x4 c4 = (f32x4){1.f, 1.f, 1.f, 1.f}, s4 = (f32x4){0.f, 0.f, 0.f, 0.f};
                    if (rope) { const float* t = cs + (size_t)(row & smask) * 32 + 4 * fq; c4 = *(const f32x4*)t; s4 = *(const f32x4*)(t + 16); }
                    bf16_t* rowp = O + (size_t)row * ldc + col0;
#pragma unroll
                    for (int bj = 0; bj < 2; ++bj) {
                        f32x4 v0 = acc[ai][bj][m][0], v1 = acc[ai][bj][m][1];
                        if (rope) { const f32x4 n0 = v0 * c4 - v1 * s4, n1 = v1 * c4 + v0 * s4; v0 = n0; v1 = n1; }
                        v0 = v0 * sc; v1 = v1 * sc;
                        u32x4 w; w.x = cvt_pk_bf16(v0[0], v0[1]); w.y = cvt_pk_bf16(v0[2], v0[3]); w.z = cvt_pk_bf16(v1[0], v1[1]); w.w = cvt_pk_bf16(v1[2], v1[3]);
                        *(u32x4*)(rowp + bj * HALF) = w;
                    }
                }
        } else if (mode == 1) {
#pragma unroll
            for (int ai = 0; ai < 2; ++ai)
#pragma unroll
                for (int m = 0; m < 4; ++m) {
                    bf16_t* rowp = O + (size_t)(row0 + ai * HALF + m * 16) * ldc + col0;
#pragma unroll
                    for (int bj = 0; bj < 2; ++bj) {
                        const f32x4 v0 = acc[ai][bj][m][0], v1 = acc[ai][bj][m][1];
                        u32x4 w; w.x = cvt_pk_bf16(v0[0], v0[1]); w.y = cvt_pk_bf16(v0[2], v0[3]); w.z = cvt_pk_bf16(v1[0], v1[1]); w.w = cvt_pk_bf16(v1[2], v1[3]);
                        *(u32x4*)(rowp + bj * HALF) = w;
                    }
                }
        } else if (mode == 2) {
#pragma unroll
            for (int ai = 0; ai < 2; ++ai)
#pragma unroll
                for (int m = 0; m < 4; ++m) {
                    const int row = row0 + ai * HALF + m * 16;
                    bf16_t* rowp = O + (size_t)row * ldc + col0;
                    float s = 0.f;
#pragma unroll
                    for (int bj = 0; bj < 2; ++bj) {
                        const f32x4 v0 = acc[ai][bj][m][0], v1 = acc[ai][bj][m][1];
                        s += (v0[0] * v0[0] + v0[1] * v0[1]) + (v0[2] * v0[2] + v0[3] * v0[3]) + (v1[0] * v1[0] + v1[1] * v1[1]) + (v1[2] * v1[2] + v1[3] * v1[3]);
                        u32x4 w; w.x = cvt_pk_bf16(v0[0], v0[1]); w.y = cvt_pk_bf16(v0[2], v0[3]); w.z = cvt_pk_bf16(v1[0], v1[1]); w.w = cvt_pk_bf16(v1[2], v1[3]);
                        *(u32x4*)(rowp + bj * HALF) = w;
                    }
                    s += __shfl_xor(s, 16); s += __shfl_xor(s, 32);
                    if (fq == 0) ss[(size_t)row * 16 + u.pn * 4 + wc] = s;
                }
        } else {
            f32x4 sv[2][2];
#pragma unroll
            for (int bj = 0; bj < 2; ++bj) { sv[bj][0] = *(const f32x4*)(scale + col0 + bj * HALF); sv[bj][1] = *(const f32x4*)(scale + col0 + bj * HALF + 4); }
#pragma unroll
            for (int ai = 0; ai < 2; ++ai)
#pragma unroll
                for (int m = 0; m < 4; ++m) {
                    bf16_t* rowp = O + (size_t)(row0 + ai * HALF + m * 16) * ldc + col0;
#pragma unroll
                    for (int bj = 0; bj < 2; ++bj) {
                        const u32x4 gw = *(const u32x4*)(rowp + 2048 + bj * HALF);
                        f32x4 v0 = acc[ai][bj][m][0] * sv[bj][0], v1 = acc[ai][bj][m][1] * sv[bj][1];
                        v0[0] *= silu_f(bf_lo(gw.x)); v0[1] *= silu_f(bf_hi(gw.x)); v0[2] *= silu_f(bf_lo(gw.y)); v0[3] *= silu_f(bf_hi(gw.y));
                        v1[0] *= silu_f(bf_lo(gw.z)); v1[1] *= silu_f(bf_hi(gw.z)); v1[2] *= silu_f(bf_lo(gw.w)); v1[3] *= silu_f(bf_hi(gw.w));
                        u32x4 w; w.x = cvt_pk_bf16(v0[0], v0[1]); w.y = cvt_pk_bf16(v0[2], v0[3]); w.z = cvt_pk_bf16(v1[0], v1[1]); w.w = cvt_pk_bf16(v1[2], v1[3]);
                        *(u32x4*)(rowp + bj * HALF) = w;
                    }
                }
        }
    }
};

__device__ __forceinline__ void gemm_phase(LAS unsigned char* lds, const Gemm g, const Order& S, const Epi& E) {
    int tid_ = threadIdx.x; asm volatile("" : "+v"(tid_));
    const int tid = tid_, wid = __builtin_amdgcn_readfirstlane(tid >> 6), lane = tid & 63, wr = wid >> 2, wc = wid & 3, fr = lane & 15, fq = lane >> 4;
    const int K = g.K, nt = K / BK, lda = g.lda;
    unsigned voffA[2], voffB[2];
#pragma unroll
    for (int i = 0; i < 2; ++i) { int R, C; stage_rc(tid * 16 + i * 8192, R, C); const int Rb = (R & ~31) + perm32(R & 31);
        voffA[i] = (unsigned)(R * lda + C) * 2u; voffB[i] = (unsigned)(Rb * K + C) * 2u; }
    const size_t kstep = (size_t)(BK * 2);
    const size_t hstepA = (size_t)HALF * lda * 2, hstepB = (size_t)HALF * K * 2;
    const size_t tstepA = 2 * hstepA, tstepB = 2 * hstepB;
    const unsigned ldsw = (unsigned)wid * 1024u;
    const int aoff = lds_byte(wr * 64 + fr, fq * 8), boff = lds_byte(wc * 32 + fr, fq * 8);
#define PG8_SA(b, h) (((b) * 2 + (h)) * HTB)
#define PG8_SB(b, h) ((4 + (b) * 2 + (h)) * HTB)
#define PG8_STAGE(bufoff, gbase, voff) do { _Pragma("unroll") for (int _i = 0; _i < 2; ++_i) \
        __builtin_amdgcn_global_load_lds((const unsigned*)((const char*)(gbase) + (voff)[_i]), (LAS unsigned*)(lds + (bufoff) + ldsw + _i * 8192), 16, 0, 0); } while (0)
#define PG8_LDA(dst, b, h) do { _Pragma("unroll") for (int m = 0; m < 4; ++m) _Pragma("unroll") for (int k = 0; k < 2; ++k) dst[m][k] = *(const LAS bf16x8*)(lds + PG8_SA(b, h) + aoff + m * 2048 + k * 1024); } while (0)
#define PG8_LDB(dst, b, h) do { _Pragma("unroll") for (int n = 0; n < 2; ++n) _Pragma("unroll") for (int k = 0; k < 2; ++k) dst[n][k] = *(const LAS bf16x8*)(lds + PG8_SB(b, h) + boff + n * 2048 + k * 1024); } while (0)
#define PG8_MMA(ai, bj, At, Bt) do { __builtin_amdgcn_s_setprio(1); _Pragma("unroll") for (int m = 0; m < 4; ++m) _Pragma("unroll") for (int n = 0; n < 2; ++n) _Pragma("unroll") for (int k = 0; k < 2; ++k) \
        acc[ai][bj][m][n] = __builtin_amdgcn_mfma_f32_16x16x32_bf16(Bt[n][k], At[m][k], acc[ai][bj][m][n], 0, 0, 0); __builtin_amdgcn_s_setprio(0); } while (0)
#define PG8_WAIT_V(n) asm volatile("s_waitcnt vmcnt(" #n ")" ::: "memory")
#define PG8_WAIT_L(n) asm volatile("s_waitcnt lgkmcnt(" #n ")" ::: "memory")
#define PG8_BAR __builtin_amdgcn_s_barrier()
#define PG8_SCHED __builtin_amdgcn_sched_barrier(0)
    Unit cur, nxt; int ui = 0;
    if (!S.next(0, cur)) return;
    f32x4 acc[2][2][4][2];
#pragma unroll
    for (int a = 0; a < 2; ++a)
#pragma unroll
        for (int b = 0; b < 2; ++b)
#pragma unroll
            for (int m = 0; m < 4; ++m)
#pragma unroll
                for (int n = 0; n < 2; ++n) acc[a][b][m][n] = (f32x4){0.f, 0.f, 0.f, 0.f};
    bf16x8 At[4][2], B0[2][2], B1[2][2];
    const char* cA = (const char*)g.A + (size_t)cur.pm * tstepA; const char* cB = (const char*)g.Bt + (size_t)cur.pn * tstepB;
    PG8_STAGE(PG8_SB(0, 0), cB, voffB); PG8_STAGE(PG8_SB(0, 1), cB + hstepB, voffB); PG8_STAGE(PG8_SA(0, 0), cA, voffA); PG8_STAGE(PG8_SA(0, 1), cA + hstepA, voffA);
    if (wr == 1) PG8_BAR;
    PG8_WAIT_V(2); PG8_BAR;
    PG8_STAGE(PG8_SB(1, 0), cB + kstep, voffB); PG8_STAGE(PG8_SA(1, 0), cA + kstep, voffA); PG8_STAGE(PG8_SB(1, 1), cB + hstepB + kstep, voffB);
    PG8_WAIT_V(6); PG8_BAR;
    for (;;) {
        const bool has_next = S.next(ui + 1, nxt);
        const char* nA = has_next ? (const char*)g.A + (size_t)nxt.pm * tstepA : cA; const char* nB = has_next ? (const char*)g.Bt + (size_t)nxt.pn * tstepB : cB;
        for (int t = 0; t < nt; t += 2) {
            const bool last = (t == nt - 2);
            const char* a1 = cA + (size_t)(t + 1) * kstep;
            const char* a2 = last ? nA : cA + (size_t)(t + 2) * kstep; const char* b2 = last ? nB : cB + (size_t)(t + 2) * kstep;
            const char* a3 = a2 + kstep; const char* b3 = b2 + kstep;
            PG8_LDB(B0, 0, 0); PG8_LDB(B1, 0, 1); PG8_SCHED; PG8_LDA(At, 0, 0); PG8_STAGE(PG8_SA(1, 1), a1 + hstepA, voffA);
            PG8_WAIT_V(8); PG8_WAIT_L(0); PG8_BAR; PG8_MMA(0, 0, At, B0); PG8_MMA(0, 1, At, B1); PG8_BAR; PG8_SCHED;
            PG8_LDA(At, 0, 1); PG8_STAGE(PG8_SB(0, 0), b2, voffB); PG8_STAGE(PG8_SB(0, 1), b2 + hstepB, voffB); PG8_STAGE(PG8_SA(0, 0), a2, voffA);
            PG8_WAIT_V(8); PG8_WAIT_L(0); PG8_BAR; PG8_MMA(1, 0, At, B0); PG8_MMA(1, 1, At, B1); PG8_BAR; PG8_SCHED;
            PG8_LDB(B0, 1, 0); PG8_LDB(B1, 1, 1); PG8_SCHED; PG8_LDA(At, 1, 0); PG8_STAGE(PG8_SA(0, 1), a2 + hstepA, voffA);
            PG8_WAIT_V(8); PG8_WAIT_L(0); PG8_BAR; PG8_MMA(0, 0, At, B0); PG8_MMA(0, 1, At, B1); PG8_BAR; PG8_SCHED;
            PG8_LDA(At, 1, 1); PG8_STAGE(PG8_SB(1, 0), b3, voffB); PG8_STAGE(PG8_SB(1, 1), b3 + hstepB, voffB); PG8_STAGE(PG8_SA(1, 0), a3, voffA);
            PG8_WAIT_V(8); PG8_WAIT_L(0); PG8_BAR; PG8_MMA(1, 0, At, B0); PG8_MMA(1, 1, At, B1); PG8_BAR; PG8_SCHED;
        }
        if (wr == 0) PG8_BAR;
        E(acc, cur, wr, wc, fr, fq);
        if (!has_next) break;
#pragma unroll
        for (int a = 0; a < 2; ++a)
#pragma unroll
            for (int b = 0; b < 2; ++b)
#pragma unroll
                for (int m = 0; m < 4; ++m)
#pragma unroll
                    for (int n = 0; n < 2; ++n) acc[a][b][m][n] = (f32x4){0.f, 0.f, 0.f, 0.f};
        cur = nxt; cA = nA; cB = nB; ++ui;
        if (wr == 1) PG8_BAR;
    }
    PG8_WAIT_V(0);
    PG8_BAR;
#undef PG8_SA
#undef PG8_SB
#undef PG8_STAGE
#undef PG8_LDA
#undef PG8_LDB
#undef PG8_MMA
#undef PG8_WAIT_V
#undef PG8_WAIT_L
#undef PG8_BAR
#undef PG8_SCHED
}
}

using pg8::cvt_pk_bf16; using pg8::bf_lo; using pg8::bf_hi; using pg8::silu_f;

__device__ __forceinline__ unsigned off_b(unsigned row, unsigned ch) { return 256u * row + 16u * (ch ^ (((row & 3) << 2) | ((row >> 2) & 3))); }
__device__ __forceinline__ int crow(int r, int hi) { return (r & 3) + 8 * (r >> 2) + 4 * hi; }

__device__ __forceinline__ void glds16(const void* gsrc, unsigned lds_dst) { unsigned keep;
    asm volatile("s_mov_b32 %0, m0\n\ts_mov_b32 m0, %2\n\ts_nop 0\n\tglobal_load_lds_dwordx4 %1, off\n\ts_mov_b32 m0, %0" : "=&s"(keep) : "v"(gsrc), "s"(lds_dst) : "memory"); }
#define ASB() __builtin_amdgcn_sched_barrier(0)
__device__ __forceinline__ void attn_phase(LAS unsigned char* lds, bf16_t* QKVG, const float* sink, int S, int G, int bid) {
    constexpr unsigned OST = 272;
    for (int unit = bid; unit < (MH / 64) * 4; unit += G) {
        int tid_ = threadIdx.x; asm volatile("" : "+v"(tid_));
        const int tid = tid_, lane = tid & 63, wid = __builtin_amdgcn_readfirstlane(tid >> 6);
        const int r32 = lane & 31, hi = lane >> 5, hloc = wid & 3, sb = wid >> 2;
        const int q4 = (lane & 15) >> 2, blk = (lane >> 4) & 1, p4 = lane & 3;
        LAS unsigned char* ostg = lds + wid * (32 * OST);
        const int kvh = unit & 3, qc = unit >> 2, q0 = qc * 64;
        const int seq0 = q0 & ~(S - 1), seq1 = seq0 + S, k0 = q0 - 128;
        const int cfirst = (q0 - seq0 >= 128) ? 0 : ((q0 - seq0 >= 64) ? 1 : 2);
        const int clast = (seq1 - q0 - 64 >= 128) ? 4 : ((seq1 - q0 - 64 >= 64) ? 3 : 2);
        const int hq = kvh * 4 + hloc, qrow = q0 + sb * 32 + r32;
        bf16x8 qf[8];
        { const bf16_t* qp = QKVG + (size_t)qrow * NQKVG + hq * 128 + hi * 8;
#pragma unroll
          for (int s = 0; s < 8; ++s) qf[s] = *(const bf16x8*)(qp + 16 * s); }
        const bf16_t* kg = QKVG + ((long)k0 + (lane >> 1)) * NQKVG + 2048 + kvh * 128 + 16 * wid + 8 * (lane & 1);
        const bf16_t* vg; int vdelta;
        { const int vrow = 8 * wid + (lane >> 4), v2 = vrow + 4;
          const int ch1 = (lane & 15) ^ (((vrow & 3) << 2) | ((vrow >> 2) & 3)), ch2 = (lane & 15) ^ (((v2 & 3) << 2) | ((v2 >> 2) & 3));
          vg = QKVG + ((long)k0 + vrow) * NQKVG + 2560 + kvh * 128 + 8 * ch1; vdelta = 4 * NQKVG + 8 * (ch2 - ch1); }
#define ATT_DMA(c_) do { const unsigned nb_ = ldsb + (unsigned)((c_) % 3) * 32768u + wid * 2048u; const bf16_t* kp_ = kg + (long)(64 * (c_)) * NQKVG; const bf16_t* vp_ = vg + (long)(64 * (c_)) * NQKVG; \
            glds16(kp_, (unsigned)__builtin_amdgcn_readfirstlane(nb_)); glds16(kp_ + 32 * NQKVG, (unsigned)__builtin_amdgcn_readfirstlane(nb_ + 1024u)); \
            glds16(vp_, (unsigned)__builtin_amdgcn_readfirstlane(nb_ + 16384u)); glds16(vp_ + vdelta, (unsigned)__builtin_amdgcn_readfirstlane(nb_ + 16384u + 1024u)); } while (0)
        const unsigned ldsb = (unsigned)(uintptr_t)lds;
        float m = sink[hq] * LOG2E, l = (hi == 0) ? 1.0f : 0.0f;
        f32x16 o[4];
#pragma unroll
        for (int c = 0; c < 4; ++c)
#pragma unroll
            for (int r = 0; r < 16; ++r) o[c][r] = 0.f;
        ATT_DMA(cfirst);
        if (cfirst < clast) { ATT_DMA(cfirst + 1); asm volatile("s_waitcnt vmcnt(4)" ::: "memory"); } else { asm volatile("s_waitcnt vmcnt(0)" ::: "memory"); }
        __syncthreads();
        const unsigned kbase = (unsigned)(r32 * 32 + hi * 16);
        unsigned vaddr[4][2];
#pragma unroll
        for (int cc = 0; cc < 4; ++cc)
#pragma unroll
            for (int t = 0; t < 2; ++t) vaddr[cc][t] = 16384u + off_b(8 * t + 4 * hi + q4, 4 * cc + 2 * blk + (p4 >> 1)) + 8 * (p4 & 1);
        for (int c = cfirst; c <= clast; ++c) {
            if (c + 2 <= clast) ATT_DMA(c + 2);
            const unsigned kb = (unsigned)(c % 3) * 32768u;
            const int lt0 = 2 * c - sb;
            int tt = (lt0 >= 0) ? 0 : 1;
            const int tt_hi = (lt0 + 1 <= 8) ? 1 : 0;
            bf16x8 kf[8];
#define ATT_LOADK(tt_) do { const unsigned ka_ = kb + kbase + (unsigned)(tt_) * 1024u; _Pragma("unroll") for (int s = 0; s < 8; ++s) kf[s] = *(const LAS bf16x8*)(lds + ka_ + s * 2048); } while (0)
#define ATT_LOADV(cc) do { _Pragma("unroll") for (int s = 0; s < 2; ++s) { \
                    vl[cc][s] = __builtin_amdgcn_ds_read_tr16_b64_v4i16((LAS s16x4*)(lds + vt_ + vaddr[cc][0] + s * 4096)); \
                    vh[cc][s] = __builtin_amdgcn_ds_read_tr16_b64_v4i16((LAS s16x4*)(lds + vt_ + vaddr[cc][1] + s * 4096)); } } while (0)
            ATT_LOADK(tt);
            for (;;) {
                const int lt = lt0 + tt;
                const unsigned vt_ = kb + (unsigned)tt * 8192u;
                s16x4 vl[4][2], vh[4][2];
                ATT_LOADV(0); ATT_LOADV(1);
                ASB();
                f32x16 st;
#pragma unroll
                for (int r = 0; r < 16; ++r) st[r] = 0.f;
#pragma unroll
                for (int s = 0; s < 8; ++s) st = __builtin_amdgcn_mfma_f32_32x32x16_bf16(kf[s], qf[s], st, 0, 0, 0);
                ASB();
                const bool nxt = tt < tt_hi;
                if (nxt) ATT_LOADK(tt + 1);
                ATT_LOADV(2); ATT_LOADV(3);
                ASB();
                if (lt == 0) { int rq = r32 - 4 * hi; asm volatile("" : "+v"(rq));
#pragma unroll
                    for (int r = 0; r < 16; ++r) if (crow(r, 0) < rq) st[r] = -1e30f; }
                else if (lt == 8) { int rq = r32 - 4 * hi; asm volatile("" : "+v"(rq));
#pragma unroll
                    for (int r = 0; r < 16; ++r) if (crow(r, 0) > rq) st[r] = -1e30f; }
                float rm = fmaxf(fmaxf(st[0], st[1]), fmaxf(st[2], st[3]));
#pragma unroll
                for (int r = 4; r < 16; r += 4) rm = fmaxf(rm, fmaxf(fmaxf(st[r], st[r + 1]), fmaxf(st[r + 2], st[r + 3])));
                { auto rr = __builtin_amdgcn_permlane32_swap(__float_as_uint(rm), __float_as_uint(rm), false, false); rm = fmaxf(__uint_as_float(rr[0]), __uint_as_float(rr[1])); }
                const float mn = (rm > m + 8.0f) ? rm : m;
                const float alpha = __builtin_amdgcn_exp2f(m - mn);
                m = mn;
#pragma unroll
                for (int cc = 0; cc < 4; ++cc)
#pragma unroll
                    for (int r = 0; r < 16; ++r) o[cc][r] *= alpha;
                float ps = 0.f;
#pragma unroll
                for (int r = 0; r < 16; ++r) { st[r] = __builtin_amdgcn_exp2f(st[r] - m); ps += st[r]; }
                l = l * alpha + ps;
                bf16x8 pf[2];
#pragma unroll
                for (int s = 0; s < 2; ++s) {
                    u32x4 w; w.x = cvt_pk_bf16(st[8 * s + 0], st[8 * s + 1]); w.y = cvt_pk_bf16(st[8 * s + 2], st[8 * s + 3]);
                    w.z = cvt_pk_bf16(st[8 * s + 4], st[8 * s + 5]); w.w = cvt_pk_bf16(st[8 * s + 6], st[8 * s + 7]);
                    pf[s] = __builtin_bit_cast(bf16x8, w); }
                ASB();
#pragma unroll
                for (int cc = 0; cc < 4; ++cc)
#pragma unroll
                    for (int s = 0; s < 2; ++s) {
                        const bf16x8 vf = (bf16x8){vl[cc][s][0], vl[cc][s][1], vl[cc][s][2], vl[cc][s][3], vh[cc][s][0], vh[cc][s][1], vh[cc][s][2], vh[cc][s][3]};
                        o[cc] = __builtin_amdgcn_mfma_f32_32x32x16_bf16(vf, pf[s], o[cc], 0, 0, 0); }
                if (!nxt) break;
                ++tt;
            }
#undef ATT_LOADK
#undef ATT_LOADV
            if (c + 2 <= clast) { asm volatile("s_waitcnt vmcnt(4)" ::: "memory"); } else { asm volatile("s_waitcnt vmcnt(0)" ::: "memory"); }
            __syncthreads();
        }
#undef ATT_DMA
        { auto rr = __builtin_amdgcn_permlane32_swap(__float_as_uint(l), __float_as_uint(l), false, false); l = __uint_as_float(rr[0]) + __uint_as_float(rr[1]); }
        const float inv = 1.0f / l;
#pragma unroll
        for (int cc = 0; cc < 4; ++cc)
#pragma unroll
            for (int g4 = 0; g4 < 4; ++g4) {
                u32x2 w; w.x = cvt_pk_bf16(o[cc][4 * g4 + 0] * inv, o[cc][4 * g4 + 1] * inv); w.y = cvt_pk_bf16(o[cc][4 * g4 + 2] * inv, o[cc][4 * g4 + 3] * inv);
                *(LAS u32x2*)(ostg + r32 * OST + (32 * cc + 8 * g4 + 4 * hi) * 2) = w;
            }
        asm volatile("s_waitcnt lgkmcnt(0)" ::: "memory");
        { bf16_t* obase = QKVG + (size_t)(q0 + sb * 32) * NQKVG + hq * 128 + (lane & 15) * 8;
#pragma unroll
          for (int i = 0; i < 8; ++i) {
              const int row = 4 * i + (lane >> 4);
              const u32x4 ov = *(const LAS u32x4*)(ostg + row * OST + (lane & 15) * 16);
              bf16_t* op = obase + (size_t)row * NQKVG;
              const u32x4 gw = *(const u32x4*)(op + 3072);
              u32x4 w;
              w.x = cvt_pk_bf16(bf_lo(ov.x) * silu_f(bf_lo(gw.x)), bf_hi(ov.x) * silu_f(bf_hi(gw.x)));
              w.y = cvt_pk_bf16(bf_lo(ov.y) * silu_f(bf_lo(gw.y)), bf_hi(ov.y) * silu_f(bf_hi(gw.y)));
              w.z = cvt_pk_bf16(bf_lo(ov.z) * silu_f(bf_lo(gw.z)), bf_hi(ov.z) * silu_f(bf_hi(gw.z)));
              w.w = cvt_pk_bf16(bf_lo(ov.w) * silu_f(bf_lo(gw.w)), bf_hi(ov.w) * silu_f(bf_hi(gw.w)));
              *(u32x4*)op = w;
          } }
        __syncthreads();
    }
}
#undef ASB

__device__ __forceinline__ float wave_sum(float v) {
#pragma unroll
    for (int o = 1; o < 64; o <<= 1) v += __shfl_xor(v, o);
    return v;
}
__device__ __forceinline__ unsigned f2bf(float f) { unsigned u = __builtin_bit_cast(unsigned, f); return (u + 0x7fffu + ((u >> 16) & 1u)) >> 16; }
__device__ __forceinline__ unsigned pk2(float lo, float hi) { return f2bf(lo) | (f2bf(hi) << 16); }

__device__ __forceinline__ void p0_transpose_item(const float* W, int K, int N, bf16_t* WT, int row_off, LAS float* scr, int item, int lane, int rope) {
    const int nblk = N / 32, kb = item / nblk, nb = item % nblk, k0 = 64 * kb, n0 = 32 * nb;
#pragma unroll 8
    for (int i = 0; i < 32; ++i) { const int kk = 2 * i + (lane >> 5); scr[kk * 33 + (lane & 31)] = W[(size_t)(k0 + kk) * N + n0 + (lane & 31)]; }
    asm volatile("s_waitcnt lgkmcnt(0)" ::: "memory");
    const bool perm = rope && ((n0 & 127) == 0) && (n0 < 2560);
    const int c = lane & 7;
#pragma unroll
    for (int j = 0; j < 4; ++j) { const int n = (lane >> 3) + 8 * j;
        const int src = perm ? (((n & 7) < 4) ? (4 * (n >> 3) + (n & 7)) : (16 + 4 * (n >> 3) + ((n & 7) - 4))) : n;
        const LAS float* s = scr + (8 * c) * 33 + src;
        u32x4 o; o.x = pk2(s[0 * 33], s[1 * 33]); o.y = pk2(s[2 * 33], s[3 * 33]); o.z = pk2(s[4 * 33], s[5 * 33]); o.w = pk2(s[6 * 33], s[7 * 33]);
        *(u32x4*)(WT + (size_t)(row_off + n0 + n) * K + k0 + 8 * c) = o; }
    asm volatile("s_waitcnt lgkmcnt(0)" ::: "memory");
}

__device__ __forceinline__ void sincos_d(double a, float& sn, float& cs) {
    const double kq = __builtin_rint(a * 0.63661977236758134308);
    double s = __builtin_fma(-kq, 1.57079632679489655800e+00, a); s = __builtin_fma(-kq, 6.12323399573676603587e-17, s);
    const int qi = ((int)kq) & 3;
    const double z = s * s;
    const double ps = s + s * z * (-1.0 / 6 + z * (1.0 / 120 + z * (-1.0 / 5040 + z * (1.0 / 362880 + z * (-1.0 / 39916800)))));
    const double pc = 1.0 + z * (-0.5 + z * (1.0 / 24 + z * (-1.0 / 720 + z * (1.0 / 40320 + z * (-1.0 / 3628800 + z * (1.0 / 479001600))))));
    const double sv = (qi == 0) ? ps : (qi == 1) ? pc : (qi == 2) ? -ps : -pc;
    const double cv = (qi == 0) ? pc : (qi == 1) ? -ps : (qi == 2) ? -pc : ps;
    sn = (float)sv; cs = (float)cv;
}

#define XB_TMO      128
#define XB_XCNT(j)  (256  + 64 * (j))
#define XB_XSUB(j)  (1280 + 64 * (j))
#define XB_XGEN(j)  (2304 + 64 * (j))
#define XB_TOP      3328
#define XB_TOPGEN   3392
#define XCD_BAR_WORDS 3456
#define XB_SPIN_CAP (1u << 18)
__device__ __forceinline__ unsigned xb_ld(unsigned* p)              { return __hip_atomic_load(p, __ATOMIC_RELAXED, __HIP_MEMORY_SCOPE_AGENT); }
__device__ __forceinline__ unsigned xb_add(unsigned* p, unsigned v) { return __hip_atomic_fetch_add(p, v, __ATOMIC_RELAXED, __HIP_MEMORY_SCOPE_AGENT); }
__device__ __forceinline__ unsigned xb_xcc_id() { return (unsigned)__builtin_amdgcn_s_getreg((3 << 11) | 20) & 0xFu; }
#define XB_SPIN(cond, bar) do { unsigned _sp = 0; while (cond) { __builtin_amdgcn_s_sleep(1); \
    if ((++_sp & 255u) == 0u) { if (xb_ld(&(bar)[XB_TMO])) break; if (_sp > XB_SPIN_CAP) { atomicAdd(&(bar)[XB_TMO], 1u); break; } } } } while (0)
struct XcdBarrier { unsigned* bar; unsigned x; volatile LAS unsigned* st; };
__device__ __forceinline__ XcdBarrier xcd_barrier_post(unsigned* bar, volatile LAS unsigned* st) {
    XcdBarrier b; b.bar = bar; b.x = xb_xcc_id(); b.st = st;
    if (threadIdx.x == 0) (void)xb_add(&bar[XB_XCNT(b.x)], 1u);
    return b;
}
__device__ __forceinline__ void xcd_barrier_complete(unsigned* bar, unsigned x, unsigned& nloc, unsigned& nx) {
    const unsigned G = gridDim.x * gridDim.y * gridDim.z;
    unsigned sum, cnt, mine, sp = 0u;
    for (;;) {
        sum = 0u; cnt = 0u; mine = 0u;
#pragma unroll
        for (unsigned j = 0; j < 16; ++j) { const unsigned c = xb_ld(&bar[XB_XCNT(j)]); sum += c; cnt += (c > 0u) ? 1u : 0u; mine = (j == x) ? c : mine; }
        if (sum == G) break;
        __builtin_amdgcn_s_sleep(1);
        if ((++sp & 255u) == 0u) { if (xb_ld(&bar[XB_TMO])) break; if (sp > XB_SPIN_CAP) { atomicAdd(&bar[XB_TMO], 1u); break; } }
    }
    nloc = mine > 0u ? mine : 1u; nx = cnt > 0u ? cnt : 1u;
}
__device__ __forceinline__ void xcd_barrier(const XcdBarrier& b) {
    asm volatile("s_waitcnt vmcnt(0)" ::: "memory");
    __syncthreads();
    if (threadIdx.x == 0) {
        unsigned* bar = b.bar;
        __builtin_amdgcn_s_waitcnt(0);
        unsigned nloc = b.st[0], nx = b.st[1];
        if (nloc == 0u) { xcd_barrier_complete(bar, b.x, nloc, nx); b.st[0] = nloc; b.st[1] = nx; }
        const unsigned old = xb_add(&bar[XB_XSUB(b.x)], 1u);
        const unsigned gen = old / nloc;
        if (old + 1u == (gen + 1u) * nloc) {
            __builtin_amdgcn_fence(__ATOMIC_RELEASE, "agent");
            asm volatile("s_waitcnt vmcnt(0)" ::: "memory");
            const unsigned og = xb_add(&bar[XB_TOP], 1u);
            const unsigned tg = og / nx;
            if (og + 1u == (tg + 1u) * nx) xb_add(&bar[XB_TOPGEN], 1u);
            else XB_SPIN(xb_ld(&bar[XB_TOPGEN]) == tg, bar);
            __builtin_amdgcn_fence(__ATOMIC_ACQUIRE, "agent");
            xb_add(&bar[XB_XGEN(b.x)], 1u);
            asm volatile("s_waitcnt vmcnt(0)" ::: "memory");
        } else {
            XB_SPIN(xb_ld(&bar[XB_XGEN(b.x)]) == gen, bar);
            __builtin_amdgcn_fence(__ATOMIC_ACQUIRE, "agent");
            asm volatile("s_waitcnt vmcnt(0)" ::: "memory");
        }
    }
    __syncthreads();
}

struct Args { const float* in[11]; float* out; unsigned char* ws; int ph_lo, ph_hi; unsigned char seq[64]; };
constexpr int LDS_BYTES = 135168;

__global__ void __launch_bounds__(512) mega_fwd(Args args) {
    extern __shared__ __attribute__((aligned(16))) unsigned char lds_raw[];
    LAS unsigned char* lds = (LAS unsigned char*)lds_raw;
    cg::grid_group grid = cg::this_grid();
    volatile LAS unsigned* MISC = (volatile LAS unsigned*)(lds + 131072 + 256);
    if (threadIdx.x < 4) MISC[threadIdx.x] = 0u;
    __syncthreads();
    const XcdBarrier xbar = xcd_barrier_post((unsigned*)args.ws, MISC);

    if (args.ph_lo == 0) {
        int tid_ = threadIdx.x; asm volatile("" : "+v"(tid_));
        const int tid = tid_, lane = tid & 63, wave = __builtin_amdgcn_readfirstlane(tid >> 6);
        const int G = gridDim.x, bid = blockIdx.x, gw = bid * 8 + wave, NGW = G * 8;
        unsigned char* ws = args.ws;
        bf16_t* WinT = (bf16_t*)(ws + WS_WIN); bf16_t* WoT = (bf16_t*)(ws + WS_WO); bf16_t* PinT = (bf16_t*)(ws + WS_PIN);
        bf16_t* WgT = (bf16_t*)(ws + WS_WG); bf16_t* PoT = (bf16_t*)(ws + WS_PO); float* CS = (float*)(ws + WS_CS);
                LAS float* scr = (LAS float*)(lds + wave * 16384);
                constexpr int I_IN = 16 * 160, I_WO = 32 * 32, I_PIN = 16 * 128, I_WG = 8 * 16, I_PO = 32 * 32;
                constexpr int NITEMS = I_IN + I_WO + I_PIN + 4 * I_WG + I_PO;
                for (int it = gw; it < NITEMS; it += NGW) {
                    int r = it;
                    if (r < I_IN) { p0_transpose_item(args.in[4], 1024, 5120, WinT, 0, scr, r, lane, 1); continue; } r -= I_IN;
                    if (r < I_WO) { p0_transpose_item(args.in[6], 2048, 1024, WoT, 0, scr, r, lane, 0); continue; } r -= I_WO;
                    if (r < I_PIN) { p0_transpose_item(args.in[7], 1024, 4096, PinT, 0, scr, r, lane, 0); continue; } r -= I_PIN;
                    if (r < 4 * I_WG) { const int g = r / I_WG; p0_transpose_item(args.in[8] + (size_t)g * 512 * 512, 512, 512, WgT, g * 512, scr, r % I_WG, lane, 0); continue; } r -= 4 * I_WG;
                    p0_transpose_item(args.in[10], 2048, 1024, PoT, 0, scr, r, lane, 0);
                }
                for (int i = bid * 512 + tid; i < 16384 * 16; i += G * 512) {
                    const int pos = i >> 4, f = i & 15;
                    const float invf = (float)exp(-(double)f * (1.0 / 16.0) * 13.122363377404328);
                    const float ang = (float)pos * invf;
                    float sn, cs; sincos_d((double)ang, sn, cs);
                    CS[pos * 32 + f] = cs; CS[pos * 32 + 16 + f] = sn;
                }
            }
    for (int ph = args.ph_lo; ph < args.ph_hi; ++ph) {
        int tid_ = threadIdx.x; asm volatile("" : "+v"(tid_));
        const int tid = tid_, lane = tid & 63, wave = __builtin_amdgcn_readfirstlane(tid >> 6);
        const int G = gridDim.x, bid = blockIdx.x;
        const int gw = bid * 8 + wave, NGW = G * 8;
        size_t zoff = 0; asm volatile("" : "+s"(zoff));
        unsigned char* ws = args.ws + zoff;
    bf16_t* WinT = (bf16_t*)(ws + WS_WIN); bf16_t* WoT = (bf16_t*)(ws + WS_WO); bf16_t* PinT = (bf16_t*)(ws + WS_PIN);
    bf16_t* WgT = (bf16_t*)(ws + WS_WG); bf16_t* PoT = (bf16_t*)(ws + WS_PO);
    float* CS = (float*)(ws + WS_CS); float* SS0 = (float*)(ws + WS_SS0); float* SS1 = (float*)(ws + WS_SS1);
    bf16_t* XN = (bf16_t*)(ws + WS_XN); bf16_t* BIG = (bf16_t*)(ws + WS_BIG); bf16_t* POOL = (bf16_t*)(ws + WS_POOL); bf16_t* OUTB = (bf16_t*)(ws + WS_OUT);
    const float* npre = args.in[2]; const float* npost = args.in[3];
        const int code = args.seq[ph], part = (code == 255) ? 0 : code / 10, k = code == 255 ? 10 : code % 10;
        const int grow0 = part * MH;
        const float* xin = (grow0 < 32768) ? args.in[0] + (size_t)grow0 * DM : args.in[1] + (size_t)(grow0 - 32768) * DM;
        float* yout = args.out + (size_t)grow0 * DM;
        const int S = (grow0 < 32768) ? 16384 : 2048;
        if (k == 0) {
            for (int row = gw * 2; row < MH; row += NGW * 2) {
                f32x4 v[2][4]; float sq[2];
#pragma unroll
                for (int rr = 0; rr < 2; ++rr) { const f32x4* xr = (const f32x4*)(xin + (size_t)(row + rr) * DM) + lane;
#pragma unroll
                    for (int j = 0; j < 4; ++j) v[rr][j] = __builtin_nontemporal_load(xr + 64 * j); }
#pragma unroll
                for (int rr = 0; rr < 2; ++rr) { float s = 0.f;
#pragma unroll
                    for (int j = 0; j < 4; ++j) s += (v[rr][j].x * v[rr][j].x + v[rr][j].y * v[rr][j].y) + (v[rr][j].z * v[rr][j].z + v[rr][j].w * v[rr][j].w);
                    sq[rr] = s; }
#pragma unroll
                for (int rr = 0; rr < 2; ++rr) {
                    const float rstd = 1.0f / sqrtf(wave_sum(sq[rr]) * (1.0f / DM) + NORM_EPS);
                    u32x2* o8 = (u32x2*)(XN + (size_t)(row + rr) * DM) + lane;
#pragma unroll
                    for (int j = 0; j < 4; ++j) { const f32x4 gg = *((const f32x4*)npre + lane + 64 * j);
                        u32x2 w; w.x = pk2(v[rr][j].x * rstd * gg.x, v[rr][j].y * rstd * gg.y); w.y = pk2(v[rr][j].z * rstd * gg.z, v[rr][j].w * rstd * gg.w); o8[64 * j] = w; }
                }
            }
        } else if (k == 1 || k == 3 || k == 5 || k == 7 || k == 8) {
            pg8::Gemm g; pg8::Order O; pg8::Epi E;
            O.G = G; O.c = bid; O.grouped = 0;
            E.cs = CS; E.smask = S - 1; E.ss = SS0; E.scale = args.in[9];
            if (k == 1) { g.A = XN; g.lda = 1024; g.Bt = WinT; g.K = 1024; O.nM = MH / 256; O.nN = NQKVG / 256; E.mode = 0; E.O = BIG; E.ldc = NQKVG; }
            else if (k == 3) { g.A = BIG; g.lda = NQKVG; g.Bt = WoT; g.K = 2048; O.nM = MH / 256; O.nN = 4; E.mode = 2; E.O = OUTB; E.ldc = 1024; E.ss = SS0; }
            else if (k == 5) { g.A = XN; g.lda = 1024; g.Bt = PinT; g.K = 1024; O.nM = MH / 256; O.nN = NUG / 256; E.mode = 1; E.O = BIG; E.ldc = NUG; }
            else if (k == 7) { g.A = POOL; g.lda = 512; g.Bt = WgT; g.K = 512; O.nM = 4 * (MH / 256); O.nN = 2; O.grouped = 1; E.mode = 3; E.O = BIG; E.ldc = NUG; }
            else { g.A = BIG; g.lda = NUG; g.Bt = PoT; g.K = 2048; O.nM = MH / 256; O.nN = 4; E.mode = 2; E.O = OUTB; E.ldc = 1024; E.ss = SS1; }
            O.nwg = O.nM * O.nN;
            pg8::gemm_phase(lds, g, O, E);
        } else if (k == 2) {
            attn_phase(lds, BIG, args.in[5], S, G, bid);
        } else if (k == 4 || k == 9) {
            const float* ssp = (k == 4) ? SS0 : SS1;
            const float* base = (k == 4) ? xin : yout;
            const float* gpost = npost + ((k == 4) ? 0 : DM);
            for (int row = gw * 2; row < MH; row += NGW * 2) {
                f32x4 v[2][4]; u32x2 ow[2][4]; float rs[2], sq[2];
#pragma unroll
                for (int rr = 0; rr < 2; ++rr) {
                    const f32x4* xr = (const f32x4*)(base + (size_t)(row + rr) * DM) + lane;
                    const u32x2* orow = (const u32x2*)(OUTB + (size_t)(row + rr) * DM) + lane;
#pragma unroll
                    for (int j = 0; j < 4; ++j) { v[rr][j] = xr[64 * j]; ow[rr][j] = orow[64 * j]; }
                    rs[rr] = (lane < 16) ? ssp[(size_t)(row + rr) * 16 + lane] : 0.f;
                }
#pragma unroll
                for (int rr = 0; rr < 2; ++rr) {
                    float sp = rs[rr];
                    sp += __shfl_xor(sp, 1); sp += __shfl_xor(sp, 2); sp += __shfl_xor(sp, 4); sp += __shfl_xor(sp, 8);
                    const float r1 = 1.0f / sqrtf(__shfl(sp, 0) * (1.0f / DM) + NORM_EPS);
                    float s = 0.f;
#pragma unroll
                    for (int j = 0; j < 4; ++j) {
                        const f32x4 gg = *((const f32x4*)gpost + lane + 64 * j); const f32x4 xv = v[rr][j]; const u32x2 w = ow[rr][j];
                        f32x4 y; y.x = xv.x + bf_lo(w.x) * r1 * gg.x; y.y = xv.y + bf_hi(w.x) * r1 * gg.y; y.z = xv.z + bf_lo(w.y) * r1 * gg.z; y.w = xv.w + bf_hi(w.y) * r1 * gg.w;
                        v[rr][j] = y; s += (y.x * y.x + y.y * y.y) + (y.z * y.z + y.w * y.w);
                    }
                    sq[rr] = s;
                    f32x4* yr = (f32x4*)(yout + (size_t)(row + rr) * DM) + lane;
#pragma unroll
                    for (int j = 0; j < 4; ++j) yr[64 * j] = v[rr][j];
                }
                if (k == 4) {
#pragma unroll
                    for (int rr = 0; rr < 2; ++rr) {
                        const float rstd = 1.0f / sqrtf(wave_sum(sq[rr]) * (1.0f / DM) + NORM_EPS);
                        u32x2* o8 = (u32x2*)(XN + (size_t)(row + rr) * DM) + lane;
#pragma unroll
                        for (int j = 0; j < 4; ++j) { const f32x4 gg = *((const f32x4*)(npre + DM) + lane + 64 * j);
                            u32x2 w; w.x = pk2(v[rr][j].x * rstd * gg.x, v[rr][j].y * rstd * gg.y); w.y = pk2(v[rr][j].z * rstd * gg.z, v[rr][j].w * rstd * gg.w); o8[64 * j] = w; }
                    }
                }
            }
        } else if (k == 6) {
            const int cc = tid & 255, tsub = tid >> 8, g = cc >> 6, hw = 1 << g;
            for (int blkI = bid; blkI < MH / 64; blkI += G) {
                const int t0 = blkI * 64 + tsub * 32, seq0 = t0 & ~(S - 1), seqL = seq0 + S - 1;
                const bf16_t* ub = BIG + cc * 8;
                float sum[8];
#pragma unroll
                for (int e = 0; e < 8; ++e) sum[e] = 0.f;
                { const int lo = max(t0 - hw, seq0), hi2 = min(t0 + hw - 1, seqL);
                  for (int j = lo; j <= hi2; ++j) { const u32x4 w = *(const u32x4*)(ub + (size_t)j * NUG);
                      sum[0] += bf_lo(w.x); sum[1] += bf_hi(w.x); sum[2] += bf_lo(w.y); sum[3] += bf_hi(w.y); sum[4] += bf_lo(w.z); sum[5] += bf_hi(w.z); sum[6] += bf_lo(w.w); sum[7] += bf_hi(w.w); } }
                bf16_t* pb = POOL + ((size_t)g * MH) * 512 + (cc & 63) * 8;
                for (int t = t0; t < t0 + 32; t += 4) {
                    u32x4 cw[4], ew[4], lw[4];
#pragma unroll
                    for (int i = 0; i < 4; ++i) {
                        cw[i] = *(const u32x4*)(ub + (size_t)(t + i) * NUG);
                        ew[i] = *(const u32x4*)(ub + (size_t)min(t + i + hw, seqL) * NUG);
                        lw[i] = *(const u32x4*)(ub + (size_t)max(t + i - hw, seq0) * NUG);
                    }
#pragma unroll
                    for (int i = 0; i < 4; ++i) {
                        const int tt = t + i, lo = max(tt - hw, seq0), hi2 = min(tt + hw - 1, seqL);
                        const float rc = 1.0f / (float)(hi2 - lo + 1);
                        const u32x4 w = cw[i];
                        u32x4 o;
                        o.x = cvt_pk_bf16(sum[0] * rc - bf_lo(w.x), sum[1] * rc - bf_hi(w.x)); o.y = cvt_pk_bf16(sum[2] * rc - bf_lo(w.y), sum[3] * rc - bf_hi(w.y));
                        o.z = cvt_pk_bf16(sum[4] * rc - bf_lo(w.z), sum[5] * rc - bf_hi(w.z)); o.w = cvt_pk_bf16(sum[6] * rc - bf_lo(w.w), sum[7] * rc - bf_hi(w.w));
                        *(u32x4*)(pb + (size_t)tt * 512) = o;
                        const float fe = (tt + hw <= seqL) ? 1.0f : 0.0f, fl = (tt - hw >= seq0) ? 1.0f : 0.0f;
                        const u32x4 a = ew[i], d = lw[i];
                        sum[0] += fe * bf_lo(a.x) - fl * bf_lo(d.x); sum[1] += fe * bf_hi(a.x) - fl * bf_hi(d.x); sum[2] += fe * bf_lo(a.y) - fl * bf_lo(d.y); sum[3] += fe * bf_hi(a.y) - fl * bf_hi(d.y);
                        sum[4] += fe * bf_lo(a.z) - fl * bf_lo(d.z); sum[5] += fe * bf_hi(a.z) - fl * bf_hi(d.z); sum[6] += fe * bf_lo(a.w) - fl * bf_lo(d.w); sum[7] += fe * bf_hi(a.w) - fl * bf_hi(d.w);
                    }
                }
            }
        }
        if (ph + 1 < args.ph_hi) { if (ph == args.ph_lo) grid.sync(); else xcd_barrier(xbar); }
    }
}

extern "C" void kernel_launch(void* const* d_in, const int* in_sizes, int n_in, void* d_out, int out_size, void* d_ws, size_t ws_size, hipStream_t stream) {
    static int grid = 0;
    if (grid == 0) {
        if (n_in != 11 || ws_size < WS_END) { fprintf(stderr, "kernel_launch: unexpected n_in %d / ws_size %zu\n", n_in, ws_size); grid = -1; return; }
        int dev = 0, cus = 0, per_cu = 0;
        hipGetDevice(&dev);
        hipDeviceGetAttribute(&cus, hipDeviceAttributeMultiprocessorCount, dev);
        if (hipFuncSetAttribute((const void*)mega_fwd, hipFuncAttributeMaxDynamicSharedMemorySize, LDS_BYTES) != hipSuccess) { fprintf(stderr, "kernel_launch: hipFuncSetAttribute failed\n"); grid = -1; return; }
        if (hipOccupancyMaxActiveBlocksPerMultiprocessor(&per_cu, (const void*)mega_fwd, 512, LDS_BYTES) != hipSuccess || per_cu < 1) { fprintf(stderr, "kernel_launch: occupancy query gave %d\n", per_cu); per_cu = 1; }
        (void)hipGetLastError();
        grid = cus;
    }
    if (grid < 0) return;
    if (hipMemsetAsync(d_ws, 0, 16384, stream) != hipSuccess) { fprintf(stderr, "kernel_launch: memset failed\n"); return; }
    Args a{};
    for (int i = 0; i < 11; ++i) a.in[i] = (const float*)d_in[i];
    a.out = (float*)d_out; a.ws = (unsigned char*)d_ws; a.ph_lo = 0;
    { int n = 0;
#ifndef REP_MASK
#define REP_MASK 0
#endif
#ifndef REP_ATTN
#define REP_ATTN 0
#endif
#ifndef EXTRA_SYNCS
#define EXTRA_SYNCS 0
#endif
      for (int h = 0; h < NPART; ++h) for (int k = 0; k < 10; ++k) { a.seq[n++] = (unsigned char)(h * 10 + k); if ((REP_MASK >> k) & 1) a.seq[n++] = (unsigned char)(h * 10 + k);
          if (k == 2 && REP_ATTN) { a.seq[n++] = (unsigned char)(h * 10 + 1); a.seq[n++] = (unsigned char)(h * 10 + 2); } }
      for (int i = 0; i < EXTRA_SYNCS; ++i) a.seq[n++] = 255;
      a.ph_hi = n; }
    void* kargs[] = {&a};
    hipError_t e = hipLaunchCooperativeKernel((const void*)mega_fwd, dim3(grid), dim3(512), kargs, LDS_BYTES, stream);
    if (e != hipSuccess) fprintf(stderr, "cooperative launch failed: %s (grid %d)\n", hipGetErrorString(e), grid);
}
```

```cpp
#include <hip/hip_runtime.h>
#include <hip/hip_cooperative_groups.h>
#include <cstdio>
#include <cstdint>
namespace cg = cooperative_groups;

#define LAS __attribute__((address_space(3)))
#define GAS __attribute__((address_space(1)))
typedef unsigned short bf16_t;
typedef short bf16x8 __attribute__((ext_vector_type(8)));
typedef short s16x4 __attribute__((ext_vector_type(4)));
typedef float f32x4 __attribute__((ext_vector_type(4)));
typedef float f32x16 __attribute__((ext_vector_type(16)));
typedef unsigned u32x4 __attribute__((ext_vector_type(4)));
typedef unsigned u32x2 __attribute__((ext_vector_type(2)));

constexpr int DM = 1024;
#ifndef ATT_DRY
#define ATT_DRY -1
#endif
#ifndef MH_ROWS
#define MH_ROWS 16384
#endif
constexpr int MH = MH_ROWS;
constexpr int NPART = 65536 / MH;
constexpr int NQKVG = 5120;
constexpr int NUG = 4096;
constexpr float NORM_EPS = 1e-6f;
constexpr float LOG2E = 1.4426950408889634f;
constexpr float QSCALE = 1.4426950408889634f * 0.08838834764831845f;

constexpr size_t MiB = 1u << 20;
constexpr size_t WS_WIN = 1 * MiB;
constexpr size_t WS_WO = 11 * MiB;
constexpr size_t WS_PIN = 15 * MiB;
constexpr size_t WS_WG = 23 * MiB;
constexpr size_t WS_PO = 25 * MiB;
constexpr size_t WS_CS = 29 * MiB;
constexpr size_t WS_SS0 = 31 * MiB;
constexpr size_t WS_SS1 = 33 * MiB;
constexpr size_t WS_XN = 40 * MiB;
constexpr size_t WS_BIG = 104 * MiB;
constexpr size_t WS_X1 = 232 * MiB;
constexpr size_t WS_POOL = 360 * MiB;
constexpr size_t WS_OUT = 424 * MiB;
constexpr size_t WS_END = 488 * MiB;

#ifndef PG8_ALIGN
#define PG8_ALIGN 1
#endif
namespace pg8 {
constexpr int BM = 256, BK = 64, HALF = 128, HTB = HALF * BK * 2, STAGE_BYTES = 8 * HTB, NXCD = 8, WGM = 8;
__device__ __forceinline__ int lds_byte(int r, int c) { const int st = (r >> 4) * 2 + (c >> 5), rr = r & 15, cc = c & 31, ob = rr * 64 + cc * 2; return st * 1024 + (ob ^ (((ob >> 9) & 1) << 5)); }
__device__ __forceinline__ void stage_rc(int b, int& R, int& C) { const int st = b / 1024, sb = b % 1024, swz = sb ^ (((sb >> 9) & 1) << 5); R = (st >> 1) * 16 + swz / 64; C = (st & 1) * 32 + (swz % 64) / 2; }
__device__ __forceinline__ int perm32(int rho) { const int n = rho >> 4, i = rho & 15; return 8 * (i >> 2) + 4 * n + (i & 3); }

struct Unit { int pm, pn; };
struct Gemm { const bf16_t* A; const bf16_t* Bt; int lda, K; };

struct Order {
    int nM, nN, nwg, G, c, grouped;
    __device__ __forceinline__ bool next(int i, Unit& u) const {
        const long L = (long)i * G + c; if (L >= nwg) return false;
        if (grouped) { constexpr int NR = MH / 256; const int l = (int)L, g = l / (2 * NR), rem = l % (2 * NR); u.pm = g * NR + (rem % NR); u.pn = g * 2 + (rem / NR); return true; }
        int wgid = (int)L; { const int q = nwg / NXCD, r = nwg % NXCD, xcd = wgid % NXCD, off = wgid / NXCD; wgid = (xcd < r ? xcd * (q + 1) : r * (q + 1) + (xcd - r) * q) + off; }
        const int nig = WGM * nN, gid = wgid / nig, fm = gid * WGM, gsz = (nM - fm) < WGM ? (nM - fm) : WGM;
        u.pm = fm + ((wgid % nig) % gsz); u.pn = (wgid % nig) / gsz; return true;
    }
};

__device__ __forceinline__ unsigned cvt_pk_bf16(float lo, float hi) { unsigned r; asm volatile("v_cvt_pk_bf16_f32 %0, %1, %2" : "=v"(r) : "v"(lo), "v"(hi)); return r; }
__device__ __forceinline__ float bf_lo(unsigned w) { return __uint_as_float(w << 16); }
__device__ __forceinline__ float bf_hi(unsigned w) { return __uint_as_float(w & 0xffff0000u); }
__device__ __forceinline__ float silu_f(float g) { return g * __builtin_amdgcn_rcpf(1.0f + __builtin_amdgcn_exp2f(-g * LOG2E)); }

struct Epi {
    int mode;
    bf16_t* O; int ldc;
    const float* cs; int smask;
    float* ss;
    const float* scale;
    __device__ __forceinline__ void operator()(const f32x4 (&acc)[2][2][4][2], const Unit& u, int wr, int wc, int fr, int fq) const {
        int pm = u.pm; if (mode == 3) pm %= (MH / 256);
        const int row0 = pm * BM + wr * 64 + fr, col0 = u.pn * BM + wc * 32 + 8 * fq;
        if (mode == 0) {
            const int kind = u.pn < 8 ? 0 : (u.pn < 10 ? 1 : 2);
            const float sc = kind == 0 ? QSCALE : 1.0f;
            const bool rope = (kind < 2) && (wc == 0);
#pragma unroll
            for (int ai = 0; ai < 2; ++ai)
#pragma unroll
                for (int m = 0; m < 4; ++m) {
                    const int row = row0 + ai * HALF + m * 16;
                    f32x4 c4 = (f32x4){1.f, 1.f, 1.f, 1.f}, s4 = (f32x4){0.f, 0.f, 0.f, 0.f};
                    if (rope) { const float* t = cs + (size_t)(row & smask) * 32 + 4 * fq; c4 = *(const f32x4*)t; s4 = *(const f32x4*)(t + 16); }
                    bf16_t* rowp = O + (size_t)row * ldc + col0;
#pragma unroll
                    for (int bj = 0; bj < 2; ++bj) {
                        f32x4 v0 = acc[ai][bj][m][0], v1 = acc[ai][bj][m][1];
                        if (rope) { const f32x4 n0 = v0 * c4 - v1 * s4, n1 = v1 * c4 + v0 * s4; v0 = n0; v1 = n1; }
                        v0 = v0 * sc; v1 = v1 * sc;
                        u32x4 w; w.x = cvt_pk_bf16(v0[0], v0[1]); w.y = cvt_pk_bf16(v0[2], v0[3]); w.z = cvt_pk_bf16(v1[0], v1[1]); w.w = cvt_pk_bf16(v1[2], v1[3]);
                        *(u32x4*)(rowp + bj * HALF) = w;
                    }
                }
        } else if (mode == 1) {
#pragma unroll
            for (int ai = 0; ai < 2; ++ai)
#pragma unroll
                for (int m = 0; m < 4; ++m) {
                    bf16_t* rowp = O + (size_t)(row0 + ai * HALF + m * 16) * ldc + col0;
#pragma unroll
                    for (int bj = 0; bj < 2; ++bj) {
                        const f32x4 v0 = acc[ai][bj][m][0], v1 = acc[ai][bj][m][1];
                        u32x4 w; w.x = cvt_pk_bf16(v0[0], v0[1]); w.y = cvt_pk_bf16(v0[2], v0[3]); w.z = cvt_pk_bf16(v1[0], v1[1]); w.w = cvt_pk_bf16(v1[2], v1[3]);
                        *(u32x4*)(rowp + bj * HALF) = w;
                    }
                }
        } else if (mode == 2) {
#pragma unroll
            for (int ai = 0; ai < 2; ++ai)
#pragma unroll
                for (int m = 0; m < 4; ++m) {
                    const int row = row0 + ai * HALF + m * 16;
                    bf16_t* rowp = O + (size_t)row * ldc + col0;
                    float s = 0.f;
#pragma unroll
                    for (int bj = 0; bj < 2; ++bj) {
                        const f32x4 v0 = acc[ai][bj][m][0], v1 = acc[ai][bj][m][1];
                        s += (v0[0] * v0[0] + v0[1] * v0[1]) + (v0[2] * v0[2] + v0[3] * v0[3]) + (v1[0] * v1[0] + v1[1] * v1[1]) + (v1[2] * v1[2] + v1[3] * v1[3]);
                        u32x4 w; w.x = cvt_pk_bf16(v0[0], v0[1]); w.y = cvt_pk_bf16(v0[2], v0[3]); w.z = cvt_pk_bf16(v1[0], v1[1]); w.w = cvt_pk_bf16(v1[2], v1[3]);
                        *(u32x4*)(rowp + bj * HALF) = w;
                    }
                    s += __shfl_xor(s, 16); s += __shfl_xor(s, 32);
                    if (fq == 0) ss[(size_t)row * 16 + u.pn * 4 + wc] = s;
                }
        } else {
            f32x4 sv[2][2];
#pragma unroll
            for (int bj = 0; bj < 2; ++bj) { sv[bj][0] = *(const f32x4*)(scale + col0 + bj * HALF); sv[bj][1] = *(const f32x4*)(scale + col0 + bj * HALF + 4); }
#pragma unroll
            for (int ai = 0; ai < 2; ++ai)
#pragma unroll
                for (int m = 0; m < 4; ++m) {
                    bf16_t* rowp = O + (size_t)(row0 + ai * HALF + m * 16) * ldc + col0;
#pragma unroll
                    for (int bj = 0; bj < 2; ++bj) {
                        const u32x4 gw = *(const u32x4*)(rowp + 2048 + bj * HALF);
                        f32x4 v0 = acc[ai][bj][m][0] * sv[bj][0], v1 = acc[ai][bj][m][1] * sv[bj][1];
                        v0[0] *= silu_f(bf_lo(gw.x)); v0[1] *= silu_f(bf_hi(gw.x)); v0[2] *= silu_f(bf_lo(gw.y)); v0[3] *= silu_f(bf_hi(gw.y));
                        v1[0] *= silu_f(bf_lo(gw.z)); v1[1] *= silu_f(bf_hi(gw.z)); v1[2] *= silu_f(bf_lo(gw.w)); v1[3] *= silu_f(bf_hi(gw.w));
                        u32x4 w; w.x = cvt_pk_bf16(v0[0], v0[1]); w.y = cvt_pk_bf16(v0[2], v0[3]); w.z = cvt_pk_bf16(v1[0], v1[1]); w.w = cvt_pk_bf16(v1[2], v1[3]);
                        *(u32x4*)(rowp + bj * HALF) = w;
                    }
                }
        }
    }
};

__device__ __forceinline__ void gemm_phase(LAS unsigned char* lds, const Gemm g, const Order& S, const Epi& E) {
    int tid_ = threadIdx.x; asm volatile("" : "+v"(tid_));
    const int tid = tid_, wid = __builtin_amdgcn_readfirstlane(tid >> 6), lane = tid & 63, wr = wid >> 2, wc = wid & 3, fr = lane & 15, fq = lane >> 4;
    const int K = g.K, nt = K / BK, lda = g.lda;
    unsigned voffA[2], voffB[2];
#pragma unroll
    for (int i = 0; i < 2; ++i) { int R, C; stage_rc(tid * 16 + i * 8192, R, C); const int Rb = (R & ~31) + perm32(R & 31);
        voffA[i] = (unsigned)(R * lda + C) * 2u; voffB[i] = (unsigned)(Rb * K + C) * 2u; }
    const size_t kstep = (size_t)(BK * 2);
    const size_t hstepA = (size_t)HALF * lda * 2, hstepB = (size_t)HALF * K * 2;
    const size_t tstepA = 2 * hstepA, tstepB = 2 * hstepB;
    const unsigned ldsw = (unsigned)wid * 1024u;
    const int aoff = lds_byte(wr * 64 + fr, fq * 8), boff = lds_byte(wc * 32 + fr, fq * 8);
#define PG8_SA(b, h) (((b) * 2 + (h)) * HTB)
#define PG8_SB(b, h) ((4 + (b) * 2 + (h)) * HTB)
#define PG8_STAGE(bufoff, gbase, voff) do { _Pragma("unroll") for (int _i = 0; _i < 2; ++_i) \
        __builtin_amdgcn_global_load_lds((const unsigned*)((const char*)(gbase) + (voff)[_i]), (LAS unsigned*)(lds + (bufoff) + ldsw + _i * 8192), 16, 0, 0); } while (0)
#define PG8_LDA(dst, b, h) do { _Pragma("unroll") for (int m = 0; m < 4; ++m) _Pragma("unroll") for (int k = 0; k < 2; ++k) dst[m][k] = *(const LAS bf16x8*)(lds + PG8_SA(b, h) + aoff + m * 2048 + k * 1024); } while (0)
#define PG8_LDB(dst, b, h) do { _Pragma("unroll") for (int n = 0; n < 2; ++n) _Pragma("unroll") for (int k = 0; k < 2; ++k) dst[n][k] = *(const LAS bf16x8*)(lds + PG8_SB(b, h) + boff + n * 2048 + k * 1024); } while (0)
#define PG8_MMA(ai, bj, At, Bt) do { __builtin_amdgcn_s_setprio(1); _Pragma("unroll") for (int m = 0; m < 4; ++m) _Pragma("unroll") for (int n = 0; n < 2; ++n) _Pragma("unroll") for (int k = 0; k < 2; ++k) \
        acc[ai][bj][m][n] = __builtin_amdgcn_mfma_f32_16x16x32_bf16(Bt[n][k], At[m][k], acc[ai][bj][m][n], 0, 0, 0); __builtin_amdgcn_s_setprio(0); } while (0)
#define PG8_WAIT_V(n) asm volatile("s_waitcnt vmcnt(" #n ")" ::: "memory")
#define PG8_WAIT_L(n) asm volatile("s_waitcnt lgkmcnt(" #n ")" ::: "memory")
#define PG8_BAR __builtin_amdgcn_s_barrier()
#define PG8_SCHED __builtin_amdgcn_sched_barrier(0)
    Unit cur, nxt; int ui = 0;
    if (!S.next(0, cur)) return;
    f32x4 acc[2][2][4][2];
#pragma unroll
    for (int a = 0; a < 2; ++a)
#pragma unroll
        for (int b = 0; b < 2; ++b)
#pragma unroll
            for (int m = 0; m < 4; ++m)
#pragma unroll
                for (int n = 0; n < 2; ++n) acc[a][b][m][n] = (f32x4){0.f, 0.f, 0.f, 0.f};
    bf16x8 At[4][2], B0[2][2], B1[2][2];
    const char* cA = (const char*)g.A + (size_t)cur.pm * tstepA; const char* cB = (const char*)g.Bt + (size_t)cur.pn * tstepB;
    PG8_STAGE(PG8_SB(0, 0), cB, voffB); PG8_STAGE(PG8_SB(0, 1), cB + hstepB, voffB); PG8_STAGE(PG8_SA(0, 0), cA, voffA); PG8_STAGE(PG8_SA(0, 1), cA + hstepA, voffA);
    if (wr == 1) PG8_BAR;
    PG8_WAIT_V(2); PG8_BAR;
    PG8_STAGE(PG8_SB(1, 0), cB + kstep, voffB); PG8_STAGE(PG8_SA(1, 0), cA + kstep, voffA); PG8_STAGE(PG8_SB(1, 1), cB + hstepB + kstep, voffB);
    PG8_WAIT_V(6); PG8_BAR;
    for (;;) {
        const bool has_next = S.next(ui + 1, nxt);
        const char* nA = has_next ? (const char*)g.A + (size_t)nxt.pm * tstepA : cA; const char* nB = has_next ? (const char*)g.Bt + (size_t)nxt.pn * tstepB : cB;
        for (int t = 0; t < nt; t += 2) {
            const bool last = (t == nt - 2);
            const char* a1 = cA + (size_t)(t + 1) * kstep;
            const char* a2 = last ? nA : cA + (size_t)(t + 2) * kstep; const char* b2 = last ? nB : cB + (size_t)(t + 2) * kstep;
            const char* a3 = a2 + kstep; const char* b3 = b2 + kstep;
            PG8_LDB(B0, 0, 0); PG8_LDB(B1, 0, 1); PG8_SCHED; PG8_LDA(At, 0, 0); PG8_STAGE(PG8_SA(1, 1), a1 + hstepA, voffA);
            PG8_WAIT_V(8); PG8_WAIT_L(0); PG8_BAR; PG8_MMA(0, 0, At, B0); PG8_MMA(0, 1, At, B1); PG8_BAR; PG8_SCHED;
            PG8_LDA(At, 0, 1); PG8_STAGE(PG8_SB(0, 0), b2, voffB); PG8_STAGE(PG8_SB(0, 1), b2 + hstepB, voffB); PG8_STAGE(PG8_SA(0, 0), a2, voffA);
            PG8_WAIT_V(8); PG8_WAIT_L(0); PG8_BAR; PG8_MMA(1, 0, At, B0); PG8_MMA(1, 1, At, B1); PG8_BAR; PG8_SCHED;
            PG8_LDB(B0, 1, 0); PG8_LDB(B1, 1, 1); PG8_SCHED; PG8_LDA(At, 1, 0); PG8_STAGE(PG8_SA(0, 1), a2 + hstepA, voffA);
            PG8_WAIT_V(8); PG8_WAIT_L(0); PG8_BAR; PG8_MMA(0, 0, At, B0); PG8_MMA(0, 1, At, B1); PG8_BAR; PG8_SCHED;
            PG8_LDA(At, 1, 1); PG8_STAGE(PG8_SB(1, 0), b3, voffB); PG8_STAGE(PG8_SB(1, 1), b3 + hstepB, voffB); PG8_STAGE(PG8_SA(1, 0), a3, voffA);
            PG8_WAIT_V(8); PG8_WAIT_L(0); PG8_BAR; PG8_MMA(1, 0, At, B0); PG8_MMA(1, 1, At, B1); PG8_BAR; PG8_SCHED;
        }
#if PG8_ALIGN
        if (wr == 0) PG8_BAR;
#endif
        E(acc, cur, wr, wc, fr, fq);
        if (!has_next) break;
#pragma unroll
        for (int a = 0; a < 2; ++a)
#pragma unroll
            for (int b = 0; b < 2; ++b)
#pragma unroll
                for (int m = 0; m < 4; ++m)
#pragma unroll
                    for (int n = 0; n < 2; ++n) acc[a][b][m][n] = (f32x4){0.f, 0.f, 0.f, 0.f};
        cur = nxt; cA = nA; cB = nB; ++ui;
#if PG8_ALIGN
        if (wr == 1) PG8_BAR;
#endif
    }
    PG8_WAIT_V(0);
#if !PG8_ALIGN
    if (wr == 0) PG8_BAR;
#endif
    PG8_BAR;
#undef PG8_SA
#undef PG8_SB
#undef PG8_STAGE
#undef PG8_LDA
#undef PG8_LDB
#undef PG8_MMA
#undef PG8_WAIT_V
#undef PG8_WAIT_L
#undef PG8_BAR
#undef PG8_SCHED
}
}

using pg8::cvt_pk_bf16; using pg8::bf_lo; using pg8::bf_hi; using pg8::silu_f;

__device__ __forceinline__ unsigned off_b(unsigned row, unsigned ch) { return 256u * row + 16u * (ch ^ (((row & 3) << 2) | ((row >> 2) & 3))); }
__device__ __forceinline__ int crow(int r, int hi) { return (r & 3) + 8 * (r >> 2) + 4 * hi; }

__device__ __forceinline__ void glds16(const void* gsrc, unsigned lds_dst) { unsigned keep;
    asm volatile("s_mov_b32 %0, m0\n\ts_mov_b32 m0, %2\n\ts_nop 0\n\tglobal_load_lds_dwordx4 %1, off\n\ts_mov_b32 m0, %0" : "=&s"(keep) : "v"(gsrc), "s"(lds_dst) : "memory"); }
#define ASB() __builtin_amdgcn_sched_barrier(0)
struct AttnCtx {
    LAS unsigned char* lds; unsigned ldsb;
    int wid, r32, hi, sb, cfirst, clast;
    const bf16_t* kg; const bf16_t* vg; int vdelta;
    const bf16_t* gbase; int grow0, gcol;
    unsigned kbase; unsigned vb2[2];
};
#define ATT_DMA(X, c_) do { const unsigned nb_ = (X).ldsb + (unsigned)((c_) % 3) * 32768u + (X).wid * 2048u; const bf16_t* kp_ = (X).kg + (long)(64 * (c_)) * NQKVG; const bf16_t* vp_ = (X).vg + (long)(64 * (c_)) * NQKVG; \
            glds16(kp_, (unsigned)__builtin_amdgcn_readfirstlane(nb_)); glds16(kp_ + 32 * NQKVG, (unsigned)__builtin_amdgcn_readfirstlane(nb_ + 1024u)); \
            glds16(vp_, (unsigned)__builtin_amdgcn_readfirstlane(nb_ + 16384u)); glds16(vp_ + (X).vdelta, (unsigned)__builtin_amdgcn_readfirstlane(nb_ + 16384u + 1024u)); } while (0)
__device__ __forceinline__ float xhalf_max(float v) { auto rr = __builtin_amdgcn_permlane32_swap(__float_as_uint(v), __float_as_uint(v), false, false); return fmaxf(__uint_as_float(rr[0]), __uint_as_float(rr[1])); }

template <bool EXACT>
__device__ __forceinline__ void attn_core(const AttnCtx& X, const bf16x8 (&qf)[8], float m0, f32x16 (&o)[4], float& l_out) {
    LAS unsigned char* lds = X.lds;
    const int r32 = X.r32, hi = X.hi, sb = X.sb, cfirst = X.cfirst, clast = X.clast;
    float m = m0, l = (hi == 0) ? 1.0f : 0.0f;
    bool first = true;
#pragma unroll
    for (int c = 0; c < 4; ++c)
#pragma unroll
        for (int r = 0; r < 16; ++r) o[c][r] = 0.f;
    ATT_DMA(X, cfirst);
    if (cfirst < clast) { ATT_DMA(X, cfirst + 1); asm volatile("s_waitcnt vmcnt(4)" ::: "memory"); } else { asm volatile("s_waitcnt vmcnt(0)" ::: "memory"); }
    __syncthreads();
    for (int c = cfirst; c <= clast; ++c) {
        if (c + 2 <= clast) ATT_DMA(X, c + 2);
        if (c == clast) {
            const unsigned gs_ = X.ldsb + (unsigned)((clast + 1 + (X.wid >> 2)) % 3) * 32768u + (unsigned)(X.wid & 3) * 8192u;
            int ln_ = threadIdx.x & 63; asm volatile("" : "+v"(ln_));
            const bf16_t* gp_ = X.gbase + (size_t)(X.grow0 + (ln_ >> 4)) * NQKVG + X.gcol + (ln_ & 15) * 8;
#pragma unroll
            for (int j = 0; j < 8; ++j) { glds16(gp_, (unsigned)__builtin_amdgcn_readfirstlane(gs_ + j * 1024u)); gp_ += 4 * NQKVG; asm volatile("" : "+v"(gp_)); }
        }
        const unsigned kb = (unsigned)(c % 3) * 32768u;
        const int lt0 = 2 * c - sb;
        int tt = (lt0 >= 0) ? 0 : 1;
        const int tt_hi = (lt0 + 1 <= 8) ? 1 : 0;
        bf16x8 kf[8];
#define ATT_LOADK(tt_) do { const unsigned ka_ = kb + X.kbase + (unsigned)(tt_) * 1024u; _Pragma("unroll") for (int s = 0; s < 8; ++s) kf[s] = *(const LAS bf16x8*)(lds + ka_ + s * 2048); } while (0)
#define ATT_LOADV(cc) do { _Pragma("unroll") for (int s = 0; s < 2; ++s) { \
                    vl[cc][s] = __builtin_amdgcn_ds_read_tr16_b64_v4i16((LAS s16x4*)(lds + ((va0_ ^ (64u * (cc))) + s * 4096))); \
                    vh[cc][s] = __builtin_amdgcn_ds_read_tr16_b64_v4i16((LAS s16x4*)(lds + ((va1_ ^ (64u * (cc))) + s * 4096))); } } while (0)
        ATT_LOADK(tt);
        for (;;) {
            const int lt = lt0 + tt;
            const unsigned vt_ = kb + (unsigned)tt * 8192u, va0_ = X.vb2[0] + vt_, va1_ = X.vb2[1] + vt_;
            s16x4 vl[4][2], vh[4][2];
            ATT_LOADV(0); ATT_LOADV(1);
            ASB();
            f32x16 st;
#pragma unroll
            for (int r = 0; r < 16; ++r) st[r] = 0.f;
#pragma unroll
            for (int s = 0; s < 8; ++s) st = __builtin_amdgcn_mfma_f32_32x32x16_bf16(kf[s], qf[s], st, 0, 0, 0);
            ASB();
            const bool nxt = tt < tt_hi;
            if (nxt) ATT_LOADK(tt + 1);
            ASB();
            if (lt == 0) { int rq = r32 - 4 * hi; asm volatile("" : "+v"(rq));
#pragma unroll
                for (int r = 0; r < 16; ++r) if (crow(r, 0) < rq) st[r] = -1e30f; }
            else if (lt == 8) { int rq = r32 - 4 * hi; asm volatile("" : "+v"(rq));
#pragma unroll
                for (int r = 0; r < 16; ++r) if (crow(r, 0) > rq) st[r] = -1e30f; }
            float ps = 0.f;
            if (EXACT) {
                float rm = fmaxf(fmaxf(st[0], st[1]), fmaxf(st[2], st[3]));
#pragma unroll
                for (int r = 4; r < 16; r += 4) rm = fmaxf(rm, fmaxf(fmaxf(st[r], st[r + 1]), fmaxf(st[r + 2], st[r + 3])));
                rm = xhalf_max(rm);
                const float mn = fmaxf(m, rm), alpha = __builtin_amdgcn_exp2f(m - mn);
                m = mn;
#pragma unroll
                for (int cc = 0; cc < 4; ++cc)
#pragma unroll
                    for (int r = 0; r < 16; ++r) o[cc][r] *= alpha;
#pragma unroll
                for (int r = 0; r < 16; ++r) { st[r] = __builtin_amdgcn_exp2f(st[r] - m); ps += st[r]; }
                l = l * alpha + ps;
            } else {
                if (first) {
                    float rm = fmaxf(fmaxf(st[0], st[1]), fmaxf(st[2], st[3]));
#pragma unroll
                    for (int r = 4; r < 16; r += 4) rm = fmaxf(rm, fmaxf(fmaxf(st[r], st[r + 1]), fmaxf(st[r + 2], st[r + 3])));
                    rm = xhalf_max(rm);
                    m = fmaxf(m0, rm);
                    l = (hi == 0) ? __builtin_amdgcn_exp2f(m0 - m) : 0.0f;
                    first = false;
                }
#pragma unroll
                for (int r = 0; r < 16; ++r) { st[r] = __builtin_amdgcn_exp2f(st[r] - m); ps += st[r]; }
                l += ps;
            }
            bf16x8 pf[2];
#pragma unroll
            for (int s = 0; s < 2; ++s) {
                u32x4 w; w.x = cvt_pk_bf16(st[8 * s + 0], st[8 * s + 1]); w.y = cvt_pk_bf16(st[8 * s + 2], st[8 * s + 3]);
                w.z = cvt_pk_bf16(st[8 * s + 4], st[8 * s + 5]); w.w = cvt_pk_bf16(st[8 * s + 6], st[8 * s + 7]);
                pf[s] = __builtin_bit_cast(bf16x8, w); }
            ASB();
            ATT_LOADV(2); ATT_LOADV(3);
            ASB();
#pragma unroll
            for (int cc = 0; cc < 2; ++cc)
#pragma unroll
                for (int s = 0; s < 2; ++s) {
                    const bf16x8 vf = (bf16x8){vl[cc][s][0], vl[cc][s][1], vl[cc][s][2], vl[cc][s][3], vh[cc][s][0], vh[cc][s][1], vh[cc][s][2], vh[cc][s][3]};
                    o[cc] = __builtin_amdgcn_mfma_f32_32x32x16_bf16(vf, pf[s], o[cc], 0, 0, 0); }
            ASB();
#pragma unroll
            for (int cc = 2; cc < 4; ++cc)
#pragma unroll
                for (int s = 0; s < 2; ++s) {
                    const bf16x8 vf = (bf16x8){vl[cc][s][0], vl[cc][s][1], vl[cc][s][2], vl[cc][s][3], vh[cc][s][0], vh[cc][s][1], vh[cc][s][2], vh[cc][s][3]};
                    o[cc] = __builtin_amdgcn_mfma_f32_32x32x16_bf16(vf, pf[s], o[cc], 0, 0, 0); }
            if (!nxt) break;
            ++tt;
        }
#undef ATT_LOADK
#undef ATT_LOADV
        if (c + 2 <= clast) { asm volatile("s_waitcnt vmcnt(4)" ::: "memory"); } else { asm volatile("s_waitcnt vmcnt(0)" ::: "memory"); }
        __syncthreads();
    }
    l_out = l;
}

__device__ __forceinline__ void attn_phase(LAS unsigned char* lds, bf16_t* QKVG, const float* sink, int S, int G, int bid) {
    volatile LAS unsigned* wgflag = (volatile LAS unsigned*)(lds + 131072 + 512);
    for (int unit = bid; unit < (MH / 64) * 4; unit += G) {
        int tid_ = threadIdx.x; asm volatile("" : "+v"(tid_));
        const int tid = tid_, lane = tid & 63, wid = __builtin_amdgcn_readfirstlane(tid >> 6);
        const int r32 = lane & 31, hi = lane >> 5, hloc = wid & 3, sb = wid >> 2;
        const int q4 = (lane & 15) >> 2, blk = (lane >> 4) & 1, p4 = lane & 3;
        const int kvh = unit & 3, qc = unit >> 2, q0 = qc * 64;
        const int seq0 = q0 & ~(S - 1), seq1 = seq0 + S, k0 = q0 - 128;
        const int hq = kvh * 4 + hloc, qrow = q0 + sb * 32 + r32;
        if (tid == 0) wgflag[0] = 0u;
        bf16x8 qf[8];
        { const bf16_t* qp = QKVG + (size_t)qrow * NQKVG + hq * 128 + hi * 8;
#pragma unroll
          for (int s = 0; s < 8; ++s) qf[s] = *(const bf16x8*)(qp + 16 * s); }
        AttnCtx X;
        X.lds = lds; X.ldsb = (unsigned)(uintptr_t)lds; X.wid = wid; X.r32 = r32; X.hi = hi; X.sb = sb;
        X.cfirst = (q0 - seq0 >= 128) ? 0 : ((q0 - seq0 >= 64) ? 1 : 2);
        X.clast = (seq1 - q0 - 64 >= 128) ? 4 : ((seq1 - q0 - 64 >= 64) ? 3 : 2);
        X.kg = QKVG + ((long)k0 + (lane >> 1)) * NQKVG + 2048 + kvh * 128 + 16 * wid + 8 * (lane & 1);
        { const int vrow = 8 * wid + (lane >> 4), v2 = vrow + 4;
          const int ch1 = (lane & 15) ^ (((vrow & 3) << 2) | ((vrow >> 2) & 3)), ch2 = (lane & 15) ^ (((v2 & 3) << 2) | ((v2 >> 2) & 3));
          X.vg = QKVG + ((long)k0 + vrow) * NQKVG + 2560 + kvh * 128 + 8 * ch1; X.vdelta = 4 * NQKVG + 8 * (ch2 - ch1); }
        X.gbase = QKVG; X.grow0 = q0 + sb * 32; X.gcol = 3072 + hq * 128;
        X.kbase = (unsigned)(r32 * 32 + hi * 16);
#pragma unroll
        for (int t = 0; t < 2; ++t) X.vb2[t] = 16384u + off_b(8 * t + 4 * hi + q4, 2 * blk + (p4 >> 1)) + 8 * (p4 & 1);
        const float m0 = sink[hq] * LOG2E;
        f32x16 o[4]; float l;
        attn_core<false>(X, qf, m0, o, l);
        { auto rr = __builtin_amdgcn_permlane32_swap(__float_as_uint(l), __float_as_uint(l), false, false); l = __uint_as_float(rr[0]) + __uint_as_float(rr[1]); }
        if (__builtin_amdgcn_ballot_w64(!(l < 1e30f)) != 0ull) { if (lane == 0) wgflag[0] = 1u; }
        __syncthreads();
        if (wgflag[0] != 0u) {
            { const bf16_t* qp = QKVG + (size_t)qrow * NQKVG + hq * 128 + hi * 8;
#pragma unroll
              for (int s = 0; s < 8; ++s) qf[s] = *(const bf16x8*)(qp + 16 * s); }
            attn_core<true>(X, qf, m0, o, l);
            auto rr = __builtin_amdgcn_permlane32_swap(__float_as_uint(l), __float_as_uint(l), false, false); l = __uint_as_float(rr[0]) + __uint_as_float(rr[1]);
        }
        const float inv = 1.0f / l;
        LAS unsigned char* ostg = lds + 98304 + wid * 4096;
        const LAS unsigned char* gst = lds + (unsigned)((X.clast + 1 + (wid >> 2)) % 3) * 32768u + (unsigned)(wid & 3) * 8192u;
        bf16_t* obase = QKVG + (size_t)(q0 + sb * 32 + (lane >> 4)) * NQKVG + hq * 128 + (lane & 15) * 8;
#pragma unroll
        for (int half = 0; half < 2; ++half) {
            if ((r32 >> 4) == half) {
                const int rr = r32 & 15;
#pragma unroll
                for (int cc = 0; cc < 4; ++cc)
#pragma unroll
                    for (int g4 = 0; g4 < 4; ++g4) {
                        u32x2 w; w.x = cvt_pk_bf16(o[cc][4 * g4 + 0] * inv, o[cc][4 * g4 + 1] * inv); w.y = cvt_pk_bf16(o[cc][4 * g4 + 2] * inv, o[cc][4 * g4 + 3] * inv);
                        *(LAS u32x2*)(ostg + rr * 256 + (((4 * cc + g4) ^ rr) * 16) + 8 * hi) = w;
                    }
            }
            asm volatile("s_waitcnt lgkmcnt(0)" ::: "memory");
#pragma unroll
            for (int i = 0; i < 4; ++i) {
                const int rr = 4 * i + (lane >> 4), row = 16 * half + rr;
                const u32x4 ov = *(const LAS u32x4*)(ostg + rr * 256 + (((lane & 15) ^ rr) * 16));
                const u32x4 gw = *(const LAS u32x4*)(gst + row * 256 + (lane & 15) * 16);
                u32x4 w;
                w.x = cvt_pk_bf16(bf_lo(ov.x) * silu_f(bf_lo(gw.x)), bf_hi(ov.x) * silu_f(bf_hi(gw.x)));
                w.y = cvt_pk_bf16(bf_lo(ov.y) * silu_f(bf_lo(gw.y)), bf_hi(ov.y) * silu_f(bf_hi(gw.y)));
                w.z = cvt_pk_bf16(bf_lo(ov.z) * silu_f(bf_lo(gw.z)), bf_hi(ov.z) * silu_f(bf_hi(gw.z)));
                w.w = cvt_pk_bf16(bf_lo(ov.w) * silu_f(bf_lo(gw.w)), bf_hi(ov.w) * silu_f(bf_hi(gw.w)));
                *(u32x4*)(obase + (size_t)(row - (lane >> 4)) * NQKVG) = w;
            }
            asm volatile("s_waitcnt lgkmcnt(0)" ::: "memory");
        }
        __syncthreads();
    }
}
#undef ATT_DMA
#undef ASB

__device__ __forceinline__ float wave_sum(float v) {
#pragma unroll
    for (int o = 1; o < 64; o <<= 1) v += __shfl_xor(v, o);
    return v;
}
__device__ __forceinline__ unsigned f2bf(float f) { unsigned u = __builtin_bit_cast(unsigned, f); return (u + 0x7fffu + ((u >> 16) & 1u)) >> 16; }
__device__ __forceinline__ unsigned pk2(float lo, float hi) { return f2bf(lo) | (f2bf(hi) << 16); }

__device__ __forceinline__ void p0_transpose_item(const float* W, int K, int N, bf16_t* WT, int row_off, LAS float* scr, int item, int lane, int rope) {
    const int nblk = N / 32, kb = item / nblk, nb = item % nblk, k0 = 64 * kb, n0 = 32 * nb;
#pragma unroll 8
    for (int i = 0; i < 32; ++i) { const int kk = 2 * i + (lane >> 5); scr[kk * 33 + (lane & 31)] = W[(size_t)(k0 + kk) * N + n0 + (lane & 31)]; }
    asm volatile("s_waitcnt lgkmcnt(0)" ::: "memory");
    const bool perm = rope && ((n0 & 127) == 0) && (n0 < 2560);
    const int c = lane & 7;
#pragma unroll
    for (int j = 0; j < 4; ++j) { const int n = (lane >> 3) + 8 * j;
        const int src = perm ? (((n & 7) < 4) ? (4 * (n >> 3) + (n & 7)) : (16 + 4 * (n >> 3) + ((n & 7) - 4))) : n;
        const LAS float* s = scr + (8 * c) * 33 + src;
        u32x4 o; o.x = pk2(s[0 * 33], s[1 * 33]); o.y = pk2(s[2 * 33], s[3 * 33]); o.z = pk2(s[4 * 33], s[5 * 33]); o.w = pk2(s[6 * 33], s[7 * 33]);
        *(u32x4*)(WT + (size_t)(row_off + n0 + n) * K + k0 + 8 * c) = o; }
    asm volatile("s_waitcnt lgkmcnt(0)" ::: "memory");
}

__device__ __forceinline__ void sincos_d(double a, float& sn, float& cs) {
    const double kq = __builtin_rint(a * 0.63661977236758134308);
    double s = __builtin_fma(-kq, 1.57079632679489655800e+00, a); s = __builtin_fma(-kq, 6.12323399573676603587e-17, s);
    const int qi = ((int)kq) & 3;
    const double z = s * s;
    const double ps = s + s * z * (-1.0 / 6 + z * (1.0 / 120 + z * (-1.0 / 5040 + z * (1.0 / 362880 + z * (-1.0 / 39916800)))));
    const double pc = 1.0 + z * (-0.5 + z * (1.0 / 24 + z * (-1.0 / 720 + z * (1.0 / 40320 + z * (-1.0 / 3628800 + z * (1.0 / 479001600))))));
    const double sv = (qi == 0) ? ps : (qi == 1) ? pc : (qi == 2) ? -ps : -pc;
    const double cv = (qi == 0) ? pc : (qi == 1) ? -ps : (qi == 2) ? -pc : ps;
    sn = (float)sv; cs = (float)cv;
}

#define XB_TMO      128
#define XB_XCNT(j)  (256  + 64 * (j))
#define XB_XSUB(j)  (1280 + 64 * (j))
#define XB_XGEN(j)  (2304 + 64 * (j))
#define XB_TOP      3328
#define XB_TOPGEN   3392
#define XCD_BAR_WORDS 3456
#define XB_SPIN_CAP (1u << 18)
__device__ __forceinline__ unsigned xb_ld(unsigned* p)              { return __hip_atomic_load(p, __ATOMIC_RELAXED, __HIP_MEMORY_SCOPE_AGENT); }
__device__ __forceinline__ unsigned xb_add(unsigned* p, unsigned v) { return __hip_atomic_fetch_add(p, v, __ATOMIC_RELAXED, __HIP_MEMORY_SCOPE_AGENT); }
__device__ __forceinline__ unsigned xb_xcc_id() { return (unsigned)__builtin_amdgcn_s_getreg((3 << 11) | 20) & 0xFu; }
#define XB_SPIN(cond, bar) do { unsigned _sp = 0; while (cond) { __builtin_amdgcn_s_sleep(1); \
    if ((++_sp & 255u) == 0u) { if (xb_ld(&(bar)[XB_TMO])) break; if (_sp > XB_SPIN_CAP) { atomicAdd(&(bar)[XB_TMO], 1u); break; } } } } while (0)
struct XcdBarrier { unsigned* bar; unsigned x; volatile LAS unsigned* st; };
__device__ __forceinline__ XcdBarrier xcd_barrier_post(unsigned* bar, volatile LAS unsigned* st) {
    XcdBarrier b; b.bar = bar; b.x = xb_xcc_id(); b.st = st;
    if (threadIdx.x == 0) (void)xb_add(&bar[XB_XCNT(b.x)], 1u);
    return b;
}
__device__ __forceinline__ void xcd_barrier_complete(unsigned* bar, unsigned x, unsigned& nloc, unsigned& nx) {
    const unsigned G = gridDim.x * gridDim.y * gridDim.z;
    unsigned sum, cnt, mine, sp = 0u;
    for (;;) {
        sum = 0u; cnt = 0u; mine = 0u;
#pragma unroll
        for (unsigned j = 0; j < 16; ++j) { const unsigned c = xb_ld(&bar[XB_XCNT(j)]); sum += c; cnt += (c > 0u) ? 1u : 0u; mine = (j == x) ? c : mine; }
        if (sum == G) break;
        __builtin_amdgcn_s_sleep(1);
        if ((++sp & 255u) == 0u) { if (xb_ld(&bar[XB_TMO])) break; if (sp > XB_SPIN_CAP) { atomicAdd(&bar[XB_TMO], 1u); break; } }
    }
    nloc = mine > 0u ? mine : 1u; nx = cnt > 0u ? cnt : 1u;
}
__device__ __forceinline__ void xcd_barrier(const XcdBarrier& b) {
    asm volatile("s_waitcnt vmcnt(0)" ::: "memory");
    __syncthreads();
    if (threadIdx.x == 0) {
        unsigned* bar = b.bar;
        __builtin_amdgcn_s_waitcnt(0);
        unsigned nloc = b.st[0], nx = b.st[1];
        if (nloc == 0u) { xcd_barrier_complete(bar, b.x, nloc, nx); b.st[0] = nloc; b.st[1] = nx; }
        const unsigned old = xb_add(&bar[XB_XSUB(b.x)], 1u);
        const unsigned gen = old / nloc;
        if (old + 1u == (gen + 1u) * nloc) {
            __builtin_amdgcn_fence(__ATOMIC_RELEASE, "agent");
            asm volatile("s_waitcnt vmcnt(0)" ::: "memory");
            const unsigned og = xb_add(&bar[XB_TOP], 1u);
            const unsigned tg = og / nx;
            if (og + 1u == (tg + 1u) * nx) xb_add(&bar[XB_TOPGEN], 1u);
            else XB_SPIN(xb_ld(&bar[XB_TOPGEN]) == tg, bar);
            __builtin_amdgcn_fence(__ATOMIC_ACQUIRE, "agent");
            xb_add(&bar[XB_XGEN(b.x)], 1u);
            asm volatile("s_waitcnt vmcnt(0)" ::: "memory");
        } else {
            XB_SPIN(xb_ld(&bar[XB_XGEN(b.x)]) == gen, bar);
            __builtin_amdgcn_fence(__ATOMIC_ACQUIRE, "agent");
            asm volatile("s_waitcnt vmcnt(0)" ::: "memory");
        }
    }
    __syncthreads();
}

struct Args { const float* in[11]; float* out; unsigned char* ws; int ph_lo, ph_hi; unsigned char seq[64]; };
constexpr int LDS_BYTES = 135168;

__global__ void __launch_bounds__(512) mega_fwd(Args args) {
    extern __shared__ __attribute__((aligned(16))) unsigned char lds_raw[];
    LAS unsigned char* lds = (LAS unsigned char*)lds_raw;
    cg::grid_group grid = cg::this_grid();
    volatile LAS unsigned* MISC = (volatile LAS unsigned*)(lds + 131072 + 256);
    if (threadIdx.x < 4) MISC[threadIdx.x] = 0u;
    __syncthreads();
    const XcdBarrier xbar = xcd_barrier_post((unsigned*)args.ws, MISC);

    if (args.ph_lo == 0) {
        int tid_ = threadIdx.x; asm volatile("" : "+v"(tid_));
        const int tid = tid_, lane = tid & 63, wave = __builtin_amdgcn_readfirstlane(tid >> 6);
        const int G = gridDim.x, bid = blockIdx.x, gw = bid * 8 + wave, NGW = G * 8;
        unsigned char* ws = args.ws;
        bf16_t* WinT = (bf16_t*)(ws + WS_WIN); bf16_t* WoT = (bf16_t*)(ws + WS_WO); bf16_t* PinT = (bf16_t*)(ws + WS_PIN);
        bf16_t* WgT = (bf16_t*)(ws + WS_WG); bf16_t* PoT = (bf16_t*)(ws + WS_PO); float* CS = (float*)(ws + WS_CS);
                LAS float* scr = (LAS float*)(lds + wave * 16384);
                constexpr int I_IN = 16 * 160, I_WO = 32 * 32, I_PIN = 16 * 128, I_WG = 8 * 16, I_PO = 32 * 32;
                constexpr int NITEMS = I_IN + I_WO + I_PIN + 4 * I_WG + I_PO;
                for (int it = gw; it < NITEMS; it += NGW) {
                    int r = it;
                    if (r < I_IN) { p0_transpose_item(args.in[4], 1024, 5120, WinT, 0, scr, r, lane, 1); continue; } r -= I_IN;
                    if (r < I_WO) { p0_transpose_item(args.in[6], 2048, 1024, WoT, 0, scr, r, lane, 0); continue; } r -= I_WO;
                    if (r < I_PIN) { p0_transpose_item(args.in[7], 1024, 4096, PinT, 0, scr, r, lane, 0); continue; } r -= I_PIN;
                    if (r < 4 * I_WG) { const int g = r / I_WG; p0_transpose_item(args.in[8] + (size_t)g * 512 * 512, 512, 512, WgT, g * 512, scr, r % I_WG, lane, 0); continue; } r -= 4 * I_WG;
                    p0_transpose_item(args.in[10], 2048, 1024, PoT, 0, scr, r, lane, 0);
                }
                for (int i = bid * 512 + tid; i < 16384 * 16; i += G * 512) {
                    const int pos = i >> 4, f = i & 15;
                    const float invf = (float)exp(-(double)f * (1.0 / 16.0) * 13.122363377404328);
                    const float ang = (float)pos * invf;
                    float sn, cs; sincos_d((double)ang, sn, cs);
                    CS[pos * 32 + f] = cs; CS[pos * 32 + 16 + f] = sn;
                }
            }
    for (int ph = args.ph_lo; ph < args.ph_hi; ++ph) {
        int tid_ = threadIdx.x; asm volatile("" : "+v"(tid_));
        const int tid = tid_, lane = tid & 63, wave = __builtin_amdgcn_readfirstlane(tid >> 6);
        const int G = gridDim.x, bid = blockIdx.x;
        const int gw = bid * 8 + wave, NGW = G * 8;
        size_t zoff = 0; asm volatile("" : "+s"(zoff));
        unsigned char* ws = args.ws + zoff;
    bf16_t* WinT = (bf16_t*)(ws + WS_WIN); bf16_t* WoT = (bf16_t*)(ws + WS_WO); bf16_t* PinT = (bf16_t*)(ws + WS_PIN);
    bf16_t* WgT = (bf16_t*)(ws + WS_WG); bf16_t* PoT = (bf16_t*)(ws + WS_PO);
    float* CS = (float*)(ws + WS_CS); float* SS0 = (float*)(ws + WS_SS0); float* SS1 = (float*)(ws + WS_SS1);
    bf16_t* XN = (bf16_t*)(ws + WS_XN); bf16_t* BIG = (bf16_t*)(ws + WS_BIG); bf16_t* POOL = (bf16_t*)(ws + WS_POOL); bf16_t* OUTB = (bf16_t*)(ws + WS_OUT);
    bf16_t* XN0A = (bf16_t*)(args.out + (size_t)32768 * DM);
    bf16_t* X1B = (bf16_t*)(ws + WS_X1);
    const float* npre = args.in[2]; const float* npost = args.in[3];
        const int code = args.seq[ph], part = (code == 255) ? 0 : code / 10, k = code == 255 ? 10 : code % 10;
        const int grow0 = part * MH;
        const float* xin = (grow0 < 32768) ? args.in[0] + (size_t)grow0 * DM : args.in[1] + (size_t)(grow0 - 32768) * DM;
        float* yout = args.out + (size_t)grow0 * DM;
        const int S = (grow0 < 32768) ? 16384 : 2048;
        if (k == 0) {
            for (int row = gw * 2; row < 65536; row += NGW * 2) {
                f32x4 v[2][4]; float sq[2];
                const float* xsrc = (row < 32768) ? args.in[0] + (size_t)row * DM : args.in[1] + (size_t)(row - 32768) * DM;
#pragma unroll
                for (int rr = 0; rr < 2; ++rr) { const f32x4* xr = (const f32x4*)(xsrc + (size_t)rr * DM) + lane;
#pragma unroll
                    for (int j = 0; j < 4; ++j) v[rr][j] = __builtin_nontemporal_load(xr + 64 * j); }
#pragma unroll
                for (int rr = 0; rr < 2; ++rr) { float s = 0.f;
#pragma unroll
                    for (int j = 0; j < 4; ++j) s += (v[rr][j].x * v[rr][j].x + v[rr][j].y * v[rr][j].y) + (v[rr][j].z * v[rr][j].z + v[rr][j].w * v[rr][j].w);
                    sq[rr] = s; }
#pragma unroll
                for (int rr = 0; rr < 2; ++rr) {
                    const float rstd = 1.0f / sqrtf(wave_sum(sq[rr]) * (1.0f / DM) + NORM_EPS);
                    u32x2* o8 = (u32x2*)(XN0A + (size_t)(row + rr) * DM) + lane;
#pragma unroll
                    for (int j = 0; j < 4; ++j) { const f32x4 gg = *((const f32x4*)npre + lane + 64 * j);
                        u32x2 w; w.x = pk2(v[rr][j].x * rstd * gg.x, v[rr][j].y * rstd * gg.y); w.y = pk2(v[rr][j].z * rstd * gg.z, v[rr][j].w * rstd * gg.w); o8[64 * j] = w; }
                }
            }
        } else if (k == 1 || k == 3 || k == 5 || k == 7 || k == 8) {
            pg8::Gemm g; pg8::Order O; pg8::Epi E;
            O.G = G; O.c = bid; O.grouped = 0;
            E.cs = CS; E.smask = S - 1; E.ss = SS0; E.scale = args.in[9];
            if (k == 1) { g.A = XN0A + (size_t)grow0 * DM; g.lda = 1024; g.Bt = WinT; g.K = 1024; O.nM = MH / 256; O.nN = NQKVG / 256; E.mode = 0; E.O = BIG; E.ldc = NQKVG; }
            else if (k == 3) { g.A = BIG; g.lda = NQKVG; g.Bt = WoT; g.K = 2048; O.nM = MH / 256; O.nN = 4; E.mode = 2; E.O = OUTB; E.ldc = 1024; E.ss = SS0; }
            else if (k == 5) { g.A = XN; g.lda = 1024; g.Bt = PinT; g.K = 1024; O.nM = MH / 256; O.nN = NUG / 256; E.mode = 1; E.O = BIG; E.ldc = NUG; }
            else if (k == 7) { g.A = POOL; g.lda = 512; g.Bt = WgT; g.K = 512; O.nM = 4 * (MH / 256); O.nN = 2; O.grouped = 1; E.mode = 3; E.O = BIG; E.ldc = NUG; }
            else { g.A = BIG; g.lda = NUG; g.Bt = PoT; g.K = 2048; O.nM = MH / 256; O.nN = 4; E.mode = 2; E.O = OUTB; E.ldc = 1024; E.ss = SS1; }
            O.nwg = O.nM * O.nN;
            pg8::gemm_phase(lds, g, O, E);
        } else if (k == 2) {
            attn_phase(lds, BIG, args.in[5], S, G, bid);
        } else if (k == 4 || k == 9) {
            const float* ssp = (k == 4) ? SS0 : SS1;
            const float* gpost = npost + ((k == 4) ? 0 : DM);
            for (int row = gw * 2; row < MH; row += NGW * 2) {
                f32x4 v[2][4]; u32x2 ow[2][4]; float rs[2], sq[2];
#pragma unroll
                for (int rr = 0; rr < 2; ++rr) {
                    const u32x2* orow = (const u32x2*)(OUTB + (size_t)(row + rr) * DM) + lane;
                    if (k == 4) { const f32x4* xr = (const f32x4*)(xin + (size_t)(row + rr) * DM) + lane;
#pragma unroll
                        for (int j = 0; j < 4; ++j) v[rr][j] = __builtin_nontemporal_load(xr + 64 * j); }
                    else { const u32x2* xb = (const u32x2*)(X1B + (size_t)(row + rr) * DM) + lane;
#pragma unroll
                        for (int j = 0; j < 4; ++j) { const u32x2 w = xb[64 * j]; v[rr][j] = (f32x4){bf_lo(w.x), bf_hi(w.x), bf_lo(w.y), bf_hi(w.y)}; } }
#pragma unroll
                    for (int j = 0; j < 4; ++j) ow[rr][j] = orow[64 * j];
                    rs[rr] = (lane < 16) ? ssp[(size_t)(row + rr) * 16 + lane] : 0.f;
                }
#pragma unroll
                for (int rr = 0; rr < 2; ++rr) {
                    float sp = rs[rr];
                    sp += __shfl_xor(sp, 1); sp += __shfl_xor(sp, 2); sp += __shfl_xor(sp, 4); sp += __shfl_xor(sp, 8);
                    const float r1 = 1.0f / sqrtf(__shfl(sp, 0) * (1.0f / DM) + NORM_EPS);
                    float s = 0.f;
#pragma unroll
                    for (int j = 0; j < 4; ++j) {
                        const f32x4 gg = *((const f32x4*)gpost + lane + 64 * j); const f32x4 xv = v[rr][j]; const u32x2 w = ow[rr][j];
                        f32x4 y; y.x = xv.x + bf_lo(w.x) * r1 * gg.x; y.y = xv.y + bf_hi(w.x) * r1 * gg.y; y.z = xv.z + bf_lo(w.y) * r1 * gg.z; y.w = xv.w + bf_hi(w.y) * r1 * gg.w;
                        v[rr][j] = y; s += (y.x * y.x + y.y * y.y) + (y.z * y.z + y.w * y.w);
                    }
                    sq[rr] = s;
                    if (k == 4) { u32x2* xb = (u32x2*)(X1B + (size_t)(row + rr) * DM) + lane;
#pragma unroll
                        for (int j = 0; j < 4; ++j) { u32x2 w; w.x = pk2(v[rr][j].x, v[rr][j].y); w.y = pk2(v[rr][j].z, v[rr][j].w); xb[64 * j] = w; } }
                    else { f32x4* yr = (f32x4*)(yout + (size_t)(row + rr) * DM) + lane;
#pragma unroll
                        for (int j = 0; j < 4; ++j) __builtin_nontemporal_store(v[rr][j], yr + 64 * j); }
                }
                if (k == 4) {
#pragma unroll
                    for (int rr = 0; rr < 2; ++rr) {
                        const float rstd = 1.0f / sqrtf(wave_sum(sq[rr]) * (1.0f / DM) + NORM_EPS);
                        u32x2* o8 = (u32x2*)(XN + (size_t)(row + rr) * DM) + lane;
#pragma unroll
                        for (int j = 0; j < 4; ++j) { const f32x4 gg = *((const f32x4*)(npre + DM) + lane + 64 * j);
                            u32x2 w; w.x = pk2(v[rr][j].x * rstd * gg.x, v[rr][j].y * rstd * gg.y); w.y = pk2(v[rr][j].z * rstd * gg.z, v[rr][j].w * rstd * gg.w); o8[64 * j] = w; }
                    }
                }
            }
        } else if (k == 6) {
            const int cc = tid & 255, tsub = tid >> 8, g = cc >> 6, hw = 1 << g;
            for (int blkI = bid; blkI < MH / 64; blkI += G) {
                const int t0 = blkI * 64 + tsub * 32, seq0 = t0 & ~(S - 1), seqL = seq0 + S - 1;
                const bf16_t* ub = BIG + cc * 8;
                float sum[8];
#pragma unroll
                for (int e = 0; e < 8; ++e) sum[e] = 0.f;
                { const int lo = max(t0 - hw, seq0), hi2 = min(t0 + hw - 1, seqL);
                  for (int j = lo; j <= hi2; ++j) { const u32x4 w = *(const u32x4*)(ub + (size_t)j * NUG);
                      sum[0] += bf_lo(w.x); sum[1] += bf_hi(w.x); sum[2] += bf_lo(w.y); sum[3] += bf_hi(w.y); sum[4] += bf_lo(w.z); sum[5] += bf_hi(w.z); sum[6] += bf_lo(w.w); sum[7] += bf_hi(w.w); } }
                bf16_t* pb = POOL + ((size_t)g * MH) * 512 + (cc & 63) * 8;
                for (int t = t0; t < t0 + 32; t += 4) {
                    u32x4 cw[4], ew[4], lw[4];
#pragma unroll
                    for (int i = 0; i < 4; ++i) {
                        cw[i] = *(const u32x4*)(ub + (size_t)(t + i) * NUG);
                        ew[i] = *(const u32x4*)(ub + (size_t)min(t + i + hw, seqL) * NUG);
                        lw[i] = *(const u32x4*)(ub + (size_t)max(t + i - hw, seq0) * NUG);
                    }
#pragma unroll
                    for (int i = 0; i < 4; ++i) {
                        const int tt = t + i, lo = max(tt - hw, seq0), hi2 = min(tt + hw - 1, seqL);
                        const float rc = 1.0f / (float)(hi2 - lo + 1);
                        const u32x4 w = cw[i];
                        u32x4 o;
                        o.x = cvt_pk_bf16(sum[0] * rc - bf_lo(w.x), sum[1] * rc - bf_hi(w.x)); o.y = cvt_pk_bf16(sum[2] * rc - bf_lo(w.y), sum[3] * rc - bf_hi(w.y));
                        o.z = cvt_pk_bf16(sum[4] * rc - bf_lo(w.z), sum[5] * rc - bf_hi(w.z)); o.w = cvt_pk_bf16(sum[6] * rc - bf_lo(w.w), sum[7] * rc - bf_hi(w.w));
                        *(u32x4*)(pb + (size_t)tt * 512) = o;
                        const float fe = (tt + hw <= seqL) ? 1.0f : 0.0f, fl = (tt - hw >= seq0) ? 1.0f : 0.0f;
                        const u32x4 a = ew[i], d = lw[i];
                        sum[0] += fe * bf_lo(a.x) - fl * bf_lo(d.x); sum[1] += fe * bf_hi(a.x) - fl * bf_hi(d.x); sum[2] += fe * bf_lo(a.y) - fl * bf_lo(d.y); sum[3] += fe * bf_hi(a.y) - fl * bf_hi(d.y);
                        sum[4] += fe * bf_lo(a.z) - fl * bf_lo(d.z); sum[5] += fe * bf_hi(a.z) - fl * bf_hi(d.z); sum[6] += fe * bf_lo(a.w) - fl * bf_lo(d.w); sum[7] += fe * bf_hi(a.w) - fl * bf_hi(d.w);
                    }
                }
            }
        }
        if (ph + 1 < args.ph_hi) { if (ph == args.ph_lo) grid.sync(); else xcd_barrier(xbar); }
    }
}

extern "C" void kernel_launch(void* const* d_in, const int* in_sizes, int n_in, void* d_out, int out_size, void* d_ws, size_t ws_size, hipStream_t stream) {
    static int grid = 0;
    if (grid == 0) {
        if (n_in != 11 || ws_size < WS_END) { fprintf(stderr, "kernel_launch: unexpected n_in %d / ws_size %zu\n", n_in, ws_size); grid = -1; return; }
        int dev = 0, cus = 0, per_cu = 0;
        hipGetDevice(&dev);
        hipDeviceGetAttribute(&cus, hipDeviceAttributeMultiprocessorCount, dev);
        if (hipFuncSetAttribute((const void*)mega_fwd, hipFuncAttributeMaxDynamicSharedMemorySize, LDS_BYTES) != hipSuccess) { fprintf(stderr, "kernel_launch: hipFuncSetAttribute failed\n"); grid = -1; return; }
        if (hipOccupancyMaxActiveBlocksPerMultiprocessor(&per_cu, (const void*)mega_fwd, 512, LDS_BYTES) != hipSuccess || per_cu < 1) { fprintf(stderr, "kernel_launch: occupancy query gave %d\n", per_cu); per_cu = 1; }
        (void)hipGetLastError();
        grid = cus;
    }
    if (grid < 0) return;
    if (hipMemsetAsync(d_ws, 0, 16384, stream) != hipSuccess) { fprintf(stderr, "kernel_launch: memset failed\n"); return; }
    Args a{};
    for (int i = 0; i < 11; ++i) a.in[i] = (const float*)d_in[i];
    a.out = (float*)d_out; a.ws = (unsigned char*)d_ws; a.ph_lo = 0;
    { int n = 0;
#ifndef REP_MASK
#define REP_MASK 0
#endif
#ifndef REP_ATTN
#define REP_ATTN 0
#endif
#ifndef EXTRA_SYNCS
#define EXTRA_SYNCS 0
#endif
      for (int h = 0; h < NPART; ++h) for (int k = (h == 0 ? 0 : 1); k < 10; ++k) { a.seq[n++] = (unsigned char)(h * 10 + k); if ((REP_MASK >> k) & 1) a.seq[n++] = (unsigned char)(h * 10 + k);
          if (k == 2 && REP_ATTN) { a.seq[n++] = (unsigned char)(h * 10 + 1); a.seq[n++] = (unsigned char)(h * 10 + 2); } }
      for (int i = 0; i < EXTRA_SYNCS; ++i) a.seq[n++] = 255;
      a.ph_hi = n; }
    void* kargs[] = {&a};
    hipError_t e = hipLaunchCooperativeKernel((const void*)mega_fwd, dim3(grid), dim3(512), kargs, LDS_BYTES, stream);
    if (e != hipSuccess) fprintf(stderr, "cooperative launch failed: %s (grid %d)\n", hipGetErrorString(e), grid);
}
```

```cpp
#include <hip/hip_runtime.h>
#include <hip/hip_cooperative_groups.h>
#include <cstdio>
#include <cstdint>
namespace cg = cooperative_groups;

#define LAS __attribute__((address_space(3)))
#define GAS __attribute__((address_space(1)))
typedef unsigned short bf16_t;
typedef short bf16x8 __attribute__((ext_vector_type(8)));
typedef short s16x4 __attribute__((ext_vector_type(4)));
typedef float f32x4 __attribute__((ext_vector_type(4)));
typedef float f32x16 __attribute__((ext_vector_type(16)));
typedef unsigned u32x4 __attribute__((ext_vector_type(4)));
typedef unsigned u32x2 __attribute__((ext_vector_type(2)));

constexpr int DM = 1024;
#ifndef ATT_DRY
#define ATT_DRY -1
#endif
#ifndef MH_ROWS
#define MH_ROWS 16384
#endif
constexpr int MH = MH_ROWS;
constexpr int NPART = 65536 / MH;
constexpr int NQKVG = 5120;
constexpr int NUG = 4096;
constexpr float NORM_EPS = 1e-6f;
constexpr float LOG2E = 1.4426950408889634f;
constexpr float QSCALE = 1.4426950408889634f * 0.08838834764831845f;

constexpr size_t MiB = 1u << 20;
constexpr size_t WS_WIN = 1 * MiB;
constexpr size_t WS_WO = 11 * MiB;
constexpr size_t WS_PIN = 15 * MiB;
constexpr size_t WS_WG = 23 * MiB;
constexpr size_t WS_PO = 25 * MiB;
constexpr size_t WS_CS = 29 * MiB;
constexpr size_t WS_SS0 = 31 * MiB;
constexpr size_t WS_SS1 = 33 * MiB;
constexpr size_t WS_XN = 40 * MiB;
constexpr size_t WS_BIG = 104 * MiB;
constexpr size_t WS_X1 = 232 * MiB;
constexpr size_t WS_POOL = 360 * MiB;
constexpr size_t WS_OUT = 424 * MiB;
constexpr size_t WS_END = 488 * MiB;

#ifndef PG8_ALIGN
#define PG8_ALIGN 1
#endif
namespace pg8 {
constexpr int BM = 256, BK = 64, HALF = 128, HTB = HALF * BK * 2, STAGE_BYTES = 8 * HTB, NXCD = 8, WGM = 8;
__device__ __forceinline__ int lds_byte(int r, int c) { const int st = (r >> 4) * 2 + (c >> 5), rr = r & 15, cc = c & 31, ob = rr * 64 + cc * 2; return st * 1024 + (ob ^ (((ob >> 9) & 1) << 5)); }
__device__ __forceinline__ void stage_rc(int b, int& R, int& C) { const int st = b / 1024, sb = b % 1024, swz = sb ^ (((sb >> 9) & 1) << 5); R = (st >> 1) * 16 + swz / 64; C = (st & 1) * 32 + (swz % 64) / 2; }
__device__ __forceinline__ int perm32(int rho) { const int n = rho >> 4, i = rho & 15; return 8 * (i >> 2) + 4 * n + (i & 3); }

struct Unit { int pm, pn; };
struct Gemm { const bf16_t* A; const bf16_t* Bt; int lda, K; };

struct Order {
    int nM, nN, nwg, G, c, grouped;
    __device__ __forceinline__ bool next(int i, Unit& u) const {
        const long L = (long)i * G + c; if (L >= nwg) return false;
        if (grouped) { constexpr int NR = MH / 256; const int l = (int)L, g = l / (2 * NR), rem = l % (2 * NR); u.pm = g * NR + (rem % NR); u.pn = g * 2 + (rem / NR); return true; }
        int wgid = (int)L; { const int q = nwg / NXCD, r = nwg % NXCD, xcd = wgid % NXCD, off = wgid / NXCD; wgid = (xcd < r ? xcd * (q + 1) : r * (q + 1) + (xcd - r) * q) + off; }
        const int nig = WGM * nN, gid = wgid / nig, fm = gid * WGM, gsz = (nM - fm) < WGM ? (nM - fm) : WGM;
        u.pm = fm + ((wgid % nig) % gsz); u.pn = (wgid % nig) / gsz; return true;
    }
};

__device__ __forceinline__ unsigned cvt_pk_bf16(float lo, float hi) { unsigned r; asm volatile("v_cvt_pk_bf16_f32 %0, %1, %2" : "=v"(r) : "v"(lo), "v"(hi)); return r; }
__device__ __forceinline__ float bf_lo(unsigned w) { return __uint_as_float(w << 16); }
__device__ __forceinline__ float bf_hi(unsigned w) { return __uint_as_float(w & 0xffff0000u); }
__device__ __forceinline__ float silu_f(float g) { return g * __builtin_amdgcn_rcpf(1.0f + __builtin_amdgcn_exp2f(-g * LOG2E)); }

struct Epi {
    int mode;
    bf16_t* O; int ldc;
    const float* cs; int smask;
    float* ss;
    const float* scale;
    __device__ __forceinline__ void operator()(const f32x4 (&acc)[2][2][4][2], const Unit& u, int wr, int wc, int fr, int fq) const {
        int pm = u.pm; if (mode == 3) pm %= (MH / 256);
        const int row0 = pm * BM + wr * 64 + fr, col0 = u.pn * BM + wc * 32 + 8 * fq;
        if (mode == 0) {
            const int kind = u.pn < 8 ? 0 : (u.pn < 10 ? 1 : 2);
            const float sc = kind == 0 ? QSCALE : 1.0f;
            const bool rope = (kind < 2) && (wc == 0);
#pragma unroll
            for (int ai = 0; ai < 2; ++ai)
#pragma unroll
                for (int m = 0; m < 4; ++m) {
                    const int row = row0 + ai * HALF + m * 16;
                    f32x4 c4 = (f32x4){1.f, 1.f, 1.f, 1.f}, s4 = (f32x4){0.f, 0.f, 0.f, 0.f};
                    if (rope) { const float* t = cs + (size_t)(row & smask) * 32 + 4 * fq; c4 = *(const f32x4*)t; s4 = *(const f32x4*)(t + 16); }
                    bf16_t* rowp = O + (size_t)row * ldc + col0;
#pragma unroll
                    for (int bj = 0; bj < 2; ++bj) {
                        f32x4 v0 = acc[ai][bj][m][0], v1 = acc[ai][bj][m][1];
                        if (rope) { const f32x4 n0 = v0 * c4 - v1 * s4, n1 = v1 * c4 + v0 * s4; v0 = n0; v1 = n1; }
                        v0 = v0 * sc; v1 = v1 * sc;
                        u32x4 w; w.x = cvt_pk_bf16(v0[0], v0[1]); w.y = cvt_pk_bf16(v0[2], v0[3]); w.z = cvt_pk_bf16(v1[0], v1[1]); w.w = cvt_pk_bf16(v1[2], v1[3]);
                        *(u32x4*)(rowp + bj * HALF) = w;
                    }
                }
        } else if (mode == 1) {
#pragma unroll
            for (int ai = 0; ai < 2; ++ai)
#pragma unroll
                for (int m = 0; m < 4; ++m) {
                    bf16_t* rowp = O + (size_t)(row0 + ai * HALF + m * 16) * ldc + col0;
#pragma unroll
                    for (int bj = 0; bj < 2; ++bj) {
                        const f32x4 v0 = acc[ai][bj][m][0], v1 = acc[ai][bj][m][1];
                        u32x4 w; w.x = cvt_pk_bf16(v0[0], v0[1]); w.y = cvt_pk_bf16(v0[2], v0[3]); w.z = cvt_pk_bf16(v1[0], v1[1]); w.w = cvt_pk_bf16(v1[2], v1[3]);
                        *(u32x4*)(rowp + bj * HALF) = w;
                    }
                }
        } else if (mode == 2) {
#pragma unroll
            for (int ai = 0; ai < 2; ++ai)
#pragma unroll
                for (int m = 0; m < 4; ++m) {
                    const int row = row0 + ai * HALF + m * 16;
                    bf16_t* rowp = O + (size_t)row * ldc + col0;
                    float s = 0.f;
#pragma unroll
                    for (int bj = 0; bj < 2; ++bj) {
                        const f32x4 v0 = acc[ai][bj][m][0], v1 = acc[ai][bj][m][1];
                        s += (v0[0] * v0[0] + v0[1] * v0[1]) + (v0[2] * v0[2] + v0[3] * v0[3]) + (v1[0] * v1[0] + v1[1] * v1[1]) + (v1[2] * v1[2] + v1[3] * v1[3]);
                        u32x4 w; w.x = cvt_pk_bf16(v0[0], v0[1]); w.y = cvt_pk_bf16(v0[2], v0[3]); w.z = cvt_pk_bf16(v1[0], v1[1]); w.w = cvt_pk_bf16(v1[2], v1[3]);
                        *(u32x4*)(rowp + bj * HALF) = w;
                    }
                    s += __shfl_xor(s, 16); s += __shfl_xor(s, 32);
                    if (fq == 0) ss[(size_t)row * 16 + u.pn * 4 + wc] = s;
                }
        } else {
            f32x4 sv[2][2];
#pragma unroll
            for (int bj = 0; bj < 2; ++bj) { sv[bj][0] = *(const f32x4*)(scale + col0 + bj * HALF); sv[bj][1] = *(const f32x4*)(scale + col0 + bj * HALF + 4); }
#pragma unroll
            for (int ai = 0; ai < 2; ++ai)
#pragma unroll
                for (int m = 0; m < 4; ++m) {
                    bf16_t* rowp = O + (size_t)(row0 + ai * HALF + m * 16) * ldc + col0;
#pragma unroll
                    for (int bj = 0; bj < 2; ++bj) {
                        const u32x4 gw = *(const u32x4*)(rowp + 2048 + bj * HALF);
                        f32x4 v0 = acc[ai][bj][m][0] * sv[bj][0], v1 = acc[ai][bj][m][1] * sv[bj][1];
                        v0[0] *= silu_f(bf_lo(gw.x)); v0[1] *= silu_f(bf_hi(gw.x)); v0[2] *= silu_f(bf_lo(gw.y)); v0[3] *= silu_f(bf_hi(gw.y));
                        v1[0] *= silu_f(bf_lo(gw.z)); v1[1] *= silu_f(bf_hi(gw.z)); v1[2] *= silu_f(bf_lo(gw.w)); v1[3] *= silu_f(bf_hi(gw.w));
                        u32x4 w; w.x = cvt_pk_bf16(v0[0], v0[1]); w.y = cvt_pk_bf16(v0[2], v0[3]); w.z = cvt_pk_bf16(v1[0], v1[1]); w.w = cvt_pk_bf16(v1[2], v1[3]);
                        *(u32x4*)(rowp + bj * HALF) = w;
                    }
                }
        }
    }
};

__device__ __forceinline__ void gemm_phase(LAS unsigned char* lds, const Gemm g, const Order& S, const Epi& E) {
    int tid_ = threadIdx.x; asm volatile("" : "+v"(tid_));
    const int tid = tid_, wid = __builtin_amdgcn_readfirstlane(tid >> 6), lane = tid & 63, wr = wid >> 2, wc = wid & 3, fr = lane & 15, fq = lane >> 4;
    const int K = g.K, nt = K / BK, lda = g.lda;
    unsigned voffA[2], voffB[2];
#pragma unroll
    for (int i = 0; i < 2; ++i) { int R, C; stage_rc(tid * 16 + i * 8192, R, C); const int Rb = (R & ~31) + perm32(R & 31);
        voffA[i] = (unsigned)(R * lda + C) * 2u; voffB[i] = (unsigned)(Rb * K + C) * 2u; }
    const size_t kstep = (size_t)(BK * 2);
    const size_t hstepA = (size_t)HALF * lda * 2, hstepB = (size_t)HALF * K * 2;
    const size_t tstepA = 2 * hstepA, tstepB = 2 * hstepB;
    const unsigned ldsw = (unsigned)wid * 1024u;
    const int aoff = lds_byte(wr * 64 + fr, fq * 8), boff = lds_byte(wc * 32 + fr, fq * 8);
#define PG8_SA(b, h) (((b) * 2 + (h)) * HTB)
#define PG8_SB(b, h) ((4 + (b) * 2 + (h)) * HTB)
#define PG8_STAGE(bufoff, gbase, voff) do { _Pragma("unroll") for (int _i = 0; _i < 2; ++_i) \
        __builtin_amdgcn_global_load_lds((const unsigned*)((const char*)(gbase) + (voff)[_i]), (LAS unsigned*)(lds + (bufoff) + ldsw + _i * 8192), 16, 0, 0); } while (0)
#define PG8_LDA(dst, b, h) do { _Pragma("unroll") for (int m = 0; m < 4; ++m) _Pragma("unroll") for (int k = 0; k < 2; ++k) dst[m][k] = *(const LAS bf16x8*)(lds + PG8_SA(b, h) + aoff + m * 2048 + k * 1024); } while (0)
#define PG8_LDB(dst, b, h) do { _Pragma("unroll") for (int n = 0; n < 2; ++n) _Pragma("unroll") for (int k = 0; k < 2; ++k) dst[n][k] = *(const LAS bf16x8*)(lds + PG8_SB(b, h) + boff + n * 2048 + k * 1024); } while (0)
#define PG8_MMA(ai, bj, At, Bt) do { __builtin_amdgcn_s_setprio(1); _Pragma("unroll") for (int m = 0; m < 4; ++m) _Pragma("unroll") for (int n = 0; n < 2; ++n) _Pragma("unroll") for (int k = 0; k < 2; ++k) \
        acc[ai][bj][m][n] = __builtin_amdgcn_mfma_f32_16x16x32_bf16(Bt[n][k], At[m][k], acc[ai][bj][m][n], 0, 0, 0); __builtin_amdgcn_s_setprio(0); } while (0)
#define PG8_WAIT_V(n) asm volatile("s_waitcnt vmcnt(" #n ")" ::: "memory")
#define PG8_WAIT_L(n) asm volatile("s_waitcnt lgkmcnt(" #n ")" ::: "memory")
#define PG8_BAR __builtin_amdgcn_s_barrier()
#define PG8_SCHED __builtin_amdgcn_sched_barrier(0)
    Unit cur, nxt; int ui = 0;
    if (!S.next(0, cur)) return;
    f32x4 acc[2][2][4][2];
#pragma unroll
    for (int a = 0; a < 2; ++a)
#pragma unroll
        for (int b = 0; b < 2; ++b)
#pragma unroll
            for (int m = 0; m < 4; ++m)
#pragma unroll
                for (int n = 0; n < 2; ++n) acc[a][b][m][n] = (f32x4){0.f, 0.f, 0.f, 0.f};
    bf16x8 At[4][2], B0[2][2], B1[2][2];
    const char* cA = (const char*)g.A + (size_t)cur.pm * tstepA; const char* cB = (const char*)g.Bt + (size_t)cur.pn * tstepB;
    PG8_STAGE(PG8_SB(0, 0), cB, voffB); PG8_STAGE(PG8_SB(0, 1), cB + hstepB, voffB); PG8_STAGE(PG8_SA(0, 0), cA, voffA); PG8_STAGE(PG8_SA(0, 1), cA + hstepA, voffA);
    if (wr == 1) PG8_BAR;
    PG8_WAIT_V(2); PG8_BAR;
    PG8_STAGE(PG8_SB(1, 0), cB + kstep, voffB); PG8_STAGE(PG8_SA(1, 0), cA + kstep, voffA); PG8_STAGE(PG8_SB(1, 1), cB + hstepB + kstep, voffB);
    PG8_WAIT_V(6); PG8_BAR;
    for (;;) {
        const bool has_next = S.next(ui + 1, nxt);
        const char* nA = has_next ? (const char*)g.A + (size_t)nxt.pm * tstepA : cA; const char* nB = has_next ? (const char*)g.Bt + (size_t)nxt.pn * tstepB : cB;
        for (int t = 0; t < nt; t += 2) {
            const bool last = (t == nt - 2);
            const char* a1 = cA + (size_t)(t + 1) * kstep;
            const char* a2 = last ? nA : cA + (size_t)(t + 2) * kstep; const char* b2 = last ? nB : cB + (size_t)(t + 2) * kstep;
            const char* a3 = a2 + kstep; const char* b3 = b2 + kstep;
            PG8_LDB(B0, 0, 0); PG8_LDB(B1, 0, 1); PG8_SCHED; PG8_LDA(At, 0, 0); PG8_STAGE(PG8_SA(1, 1), a1 + hstepA, voffA);
            PG8_WAIT_V(8); PG8_WAIT_L(0); PG8_BAR; PG8_MMA(0, 0, At, B0); PG8_MMA(0, 1, At, B1); PG8_BAR; PG8_SCHED;
            PG8_LDA(At, 0, 1); PG8_STAGE(PG8_SB(0, 0), b2, voffB); PG8_STAGE(PG8_SB(0, 1), b2 + hstepB, voffB); PG8_STAGE(PG8_SA(0, 0), a2, voffA);
            PG8_WAIT_V(8); PG8_WAIT_L(0); PG8_BAR; PG8_MMA(1, 0, At, B0); PG8_MMA(1, 1, At, B1); PG8_BAR; PG8_SCHED;
            PG8_LDB(B0, 1, 0); PG8_LDB(B1, 1, 1); PG8_SCHED; PG8_LDA(At, 1, 0); PG8_STAGE(PG8_SA(0, 1), a2 + hstepA, voffA);
            PG8_WAIT_V(8); PG8_WAIT_L(0); PG8_BAR; PG8_MMA(0, 0, At, B0); PG8_MMA(0, 1, At, B1); PG8_BAR; PG8_SCHED;
            PG8_LDA(At, 1, 1); PG8_STAGE(PG8_SB(1, 0), b3, voffB); PG8_STAGE(PG8_SB(1, 1), b3 + hstepB, voffB); PG8_STAGE(PG8_SA(1, 0), a3, voffA);
            PG8_WAIT_V(8); PG8_WAIT_L(0); PG8_BAR; PG8_MMA(1, 0, At, B0); PG8_MMA(1, 1, At, B1); PG8_BAR; PG8_SCHED;
        }
#if PG8_ALIGN
        if (wr == 0) PG8_BAR;
#endif
        E(acc, cur, wr, wc, fr, fq);
        if (!has_next) break;
#pragma unroll
        for (int a = 0; a < 2; ++a)
#pragma unroll
            for (int b = 0; b < 2; ++b)
#pragma unroll
                for (int m = 0; m < 4; ++m)
#pragma unroll
                    for (int n = 0; n < 2; ++n) acc[a][b][m][n] = (f32x4){0.f, 0.f, 0.f, 0.f};
        cur = nxt; cA = nA; cB = nB; ++ui;
#if PG8_ALIGN
        if (wr == 1) PG8_BAR;
#endif
    }
    PG8_WAIT_V(0);
#if !PG8_ALIGN
    if (wr == 0) PG8_BAR;
#endif
    PG8_BAR;
#undef PG8_SA
#undef PG8_SB
#undef PG8_STAGE
#undef PG8_LDA
#undef PG8_LDB
#undef PG8_MMA
#undef PG8_WAIT_V
#undef PG8_WAIT_L
#undef PG8_BAR
#undef PG8_SCHED
}
}

using pg8::cvt_pk_bf16; using pg8::bf_lo; using pg8::bf_hi; using pg8::silu_f;

__device__ __forceinline__ unsigned off_b(unsigned row, unsigned ch) { return 256u * row + 16u * (ch ^ (((row & 3) << 2) | ((row >> 2) & 3))); }
__device__ __forceinline__ int crow(int r, int hi) { return (r & 3) + 8 * (r >> 2) + 4 * hi; }

__device__ __forceinline__ void glds16(const void* gsrc, unsigned lds_dst) { unsigned keep;
    asm volatile("s_mov_b32 %0, m0\n\ts_mov_b32 m0, %2\n\ts_nop 0\n\tglobal_load_lds_dwordx4 %1, off\n\ts_mov_b32 m0, %0" : "=&s"(keep) : "v"(gsrc), "s"(lds_dst) : "memory"); }
#define ASB() __builtin_amdgcn_sched_barrier(0)
struct AttnCtx {
    LAS unsigned char* lds; unsigned ldsb;
    int wid, r32, hi, sb, cfirst, clast;
    const bf16_t* kg; const bf16_t* vg; int vdelta;
    const bf16_t* gbase; int grow0, gcol;
    unsigned kbase; unsigned vb2[2];
};
#define ATT_DMA(X, c_) do { const unsigned nb_ = (X).ldsb + (unsigned)((c_) % 3) * 32768u + (X).wid * 2048u; const bf16_t* kp_ = (X).kg + (long)(64 * (c_)) * NQKVG; const bf16_t* vp_ = (X).vg + (long)(64 * (c_)) * NQKVG; \
            glds16(kp_, (unsigned)__builtin_amdgcn_readfirstlane(nb_)); glds16(kp_ + 32 * NQKVG, (unsigned)__builtin_amdgcn_readfirstlane(nb_ + 1024u)); \
            glds16(vp_, (unsigned)__builtin_amdgcn_readfirstlane(nb_ + 16384u)); glds16(vp_ + (X).vdelta, (unsigned)__builtin_amdgcn_readfirstlane(nb_ + 16384u + 1024u)); } while (0)
__device__ __forceinline__ float xhalf_max(float v) { auto rr = __builtin_amdgcn_permlane32_swap(__float_as_uint(v), __float_as_uint(v), false, false); return fmaxf(__uint_as_float(rr[0]), __uint_as_float(rr[1])); }

template <bool EXACT>
__device__ __forceinline__ void attn_core(const AttnCtx& X, const bf16x8 (&qf)[8], float m0, f32x16 (&o)[4], float& l_out) {
    LAS unsigned char* lds = X.lds;
    const int r32 = X.r32, hi = X.hi, sb = X.sb, cfirst = X.cfirst, clast = X.clast;
    float m = m0, l = (hi == 0) ? 1.0f : 0.0f;
    bool first = true;
#pragma unroll
    for (int c = 0; c < 4; ++c)
#pragma unroll
        for (int r = 0; r < 16; ++r) o[c][r] = 0.f;
    ATT_DMA(X, cfirst);
    if (cfirst < clast) { ATT_DMA(X, cfirst + 1); asm volatile("s_waitcnt vmcnt(4)" ::: "memory"); } else { asm volatile("s_waitcnt vmcnt(0)" ::: "memory"); }
    __syncthreads();
    for (int c = cfirst; c <= clast; ++c) {
        if (c + 2 <= clast) ATT_DMA(X, c + 2);
        if (c == clast) {
            const unsigned gs_ = X.ldsb + (unsigned)((clast + 1 + (X.wid >> 2)) % 3) * 32768u + (unsigned)(X.wid & 3) * 8192u;
            int ln_ = threadIdx.x & 63; asm volatile("" : "+v"(ln_));
            const bf16_t* gp_ = X.gbase + (size_t)(X.grow0 + (ln_ >> 4)) * NQKVG + X.gcol + (ln_ & 15) * 8;
#pragma unroll
            for (int j = 0; j < 8; ++j) { glds16(gp_, (unsigned)__builtin_amdgcn_readfirstlane(gs_ + j * 1024u)); gp_ += 4 * NQKVG; asm volatile("" : "+v"(gp_)); }
        }
        const unsigned kb = (unsigned)(c % 3) * 32768u;
        const int lt0 = 2 * c - sb;
        int tt = (lt0 >= 0) ? 0 : 1;
        const int tt_hi = (lt0 + 1 <= 8) ? 1 : 0;
        bf16x8 kf[8];
#define ATT_LOADK(tt_) do { const unsigned ka_ = kb + X.kbase + (unsigned)(tt_) * 1024u; _Pragma("unroll") for (int s = 0; s < 8; ++s) kf[s] = *(const LAS bf16x8*)(lds + ka_ + s * 2048); } while (0)
#define ATT_LOADV(cc) do { _Pragma("unroll") for (int s = 0; s < 2; ++s) { \
                    vl[cc][s] = __builtin_amdgcn_ds_read_tr16_b64_v4i16((LAS s16x4*)(lds + ((va0_ ^ (64u * (cc))) + s * 4096))); \
                    vh[cc][s] = __builtin_amdgcn_ds_read_tr16_b64_v4i16((LAS s16x4*)(lds + ((va1_ ^ (64u * (cc))) + s * 4096))); } } while (0)
        ATT_LOADK(tt);
        for (;;) {
            const int lt = lt0 + tt;
            const unsigned vt_ = kb + (unsigned)tt * 8192u, va0_ = X.vb2[0] + vt_, va1_ = X.vb2[1] + vt_;
            s16x4 vl[4][2], vh[4][2];
            ATT_LOADV(0); ATT_LOADV(1);
            ASB();
            f32x16 st;
#pragma unroll
            for (int r = 0; r < 16; ++r) st[r] = 0.f;
#pragma unroll
            for (int s = 0; s < 8; ++s) st = __builtin_amdgcn_mfma_f32_32x32x16_bf16(kf[s], qf[s], st, 0, 0, 0);
            ASB();
            const bool nxt = tt < tt_hi;
            if (nxt) ATT_LOADK(tt + 1);
            ASB();
            if (lt == 0) { int rq = r32 - 4 * hi; asm volatile("" : "+v"(rq));
#pragma unroll
                for (int r = 0; r < 16; ++r) if (crow(r, 0) < rq) st[r] = -1e30f; }
            else if (lt == 8) { int rq = r32 - 4 * hi; asm volatile("" : "+v"(rq));
#pragma unroll
                for (int r = 0; r < 16; ++r) if (crow(r, 0) > rq) st[r] = -1e30f; }
            float ps = 0.f;
            if (EXACT) {
                float rm = fmaxf(fmaxf(st[0], st[1]), fmaxf(st[2], st[3]));
#pragma unroll
                for (int r = 4; r < 16; r += 4) rm = fmaxf(rm, fmaxf(fmaxf(st[r], st[r + 1]), fmaxf(st[r + 2], st[r + 3])));
                rm = xhalf_max(rm);
                const float mn = fmaxf(m, rm), alpha = __builtin_amdgcn_exp2f(m - mn);
                m = mn;
#pragma unroll
                for (int cc = 0; cc < 4; ++cc)
#pragma unroll
                    for (int r = 0; r < 16; ++r) o[cc][r] *= alpha;
#pragma unroll
                for (int r = 0; r < 16; ++r) { st[r] = __builtin_amdgcn_exp2f(st[r] - m); ps += st[r]; }
                l = l * alpha + ps;
            } else {
                if (first) {
                    float rm = fmaxf(fmaxf(st[0], st[1]), fmaxf(st[2], st[3]));
#pragma unroll
                    for (int r = 4; r < 16; r += 4) rm = fmaxf(rm, fmaxf(fmaxf(st[r], st[r + 1]), fmaxf(st[r + 2], st[r + 3])));
                    rm = xhalf_max(rm);
                    m = fmaxf(m0, rm);
                    l = (hi == 0) ? __builtin_amdgcn_exp2f(m0 - m) : 0.0f;
                    first = false;
                }
#pragma unroll
                for (int r = 0; r < 16; ++r) { st[r] = __builtin_amdgcn_exp2f(st[r] - m); ps += st[r]; }
                l += ps;
            }
            bf16x8 pf[2];
#pragma unroll
            for (int s = 0; s < 2; ++s) {
                u32x4 w; w.x = cvt_pk_bf16(st[8 * s + 0], st[8 * s + 1]); w.y = cvt_pk_bf16(st[8 * s + 2], st[8 * s + 3]);
                w.z = cvt_pk_bf16(st[8 * s + 4], st[8 * s + 5]); w.w = cvt_pk_bf16(st[8 * s + 6], st[8 * s + 7]);
                pf[s] = __builtin_bit_cast(bf16x8, w); }
            ASB();
            ATT_LOADV(2); ATT_LOADV(3);
            ASB();
#pragma unroll
            for (int cc = 0; cc < 2; ++cc)
#pragma unroll
                for (int s = 0; s < 2; ++s) {
                    const bf16x8 vf = (bf16x8){vl[cc][s][0], vl[cc][s][1], vl[cc][s][2], vl[cc][s][3], vh[cc][s][0], vh[cc][s][1], vh[cc][s][2], vh[cc][s][3]};
                    o[cc] = __builtin_amdgcn_mfma_f32_32x32x16_bf16(vf, pf[s], o[cc], 0, 0, 0); }
            ASB();
#pragma unroll
            for (int cc = 2; cc < 4; ++cc)
#pragma unroll
                for (int s = 0; s < 2; ++s) {
                    const bf16x8 vf = (bf16x8){vl[cc][s][0], vl[cc][s][1], vl[cc][s][2], vl[cc][s][3], vh[cc][s][0], vh[cc][s][1], vh[cc][s][2], vh[cc][s][3]};
                    o[cc] = __builtin_amdgcn_mfma_f32_32x32x16_bf16(vf, pf[s], o[cc], 0, 0, 0); }
            if (!nxt) break;
            ++tt;
        }
#undef ATT_LOADK
#undef ATT_LOADV
        if (c + 2 <= clast) { asm volatile("s_waitcnt vmcnt(4)" ::: "memory"); } else { asm volatile("s_waitcnt vmcnt(0)" ::: "memory"); }
        __syncthreads();
    }
    l_out = l;
}

__device__ __forceinline__ void attn_phase(LAS unsigned char* lds, bf16_t* QKVG, const float* sink, int S, int G, int bid) {
    volatile LAS unsigned* wgflag = (volatile LAS unsigned*)(lds + 131072 + 512);
    bf16x8 qf[8];
    for (int unit = bid; unit < (MH / 64) * 4; unit += G) {
        int tid_ = threadIdx.x; asm volatile("" : "+v"(tid_));
        const int tid = tid_, lane = tid & 63, wid = __builtin_amdgcn_readfirstlane(tid >> 6);
        const int r32 = lane & 31, hi = lane >> 5, hloc = wid & 3, sb = wid >> 2;
        const int q4 = (lane & 15) >> 2, blk = (lane >> 4) & 1, p4 = lane & 3;
        const int kvh = unit & 3, qc = unit >> 2, q0 = qc * 64;
        const int seq0 = q0 & ~(S - 1), seq1 = seq0 + S, k0 = q0 - 128;
        const int hq = kvh * 4 + hloc, qrow = q0 + sb * 32 + r32;
        if (tid == 0) wgflag[0] = 0u;
        if (unit == bid) {
            const bf16_t* qp = QKVG + (size_t)qrow * NQKVG + hq * 128 + hi * 8;
#pragma unroll
            for (int s = 0; s < 8; ++s) qf[s] = *(const bf16x8*)(qp + 16 * s); }
        AttnCtx X;
        X.lds = lds; X.ldsb = (unsigned)(uintptr_t)lds; X.wid = wid; X.r32 = r32; X.hi = hi; X.sb = sb;
        X.cfirst = (q0 - seq0 >= 128) ? 0 : ((q0 - seq0 >= 64) ? 1 : 2);
        X.clast = (seq1 - q0 - 64 >= 128) ? 4 : ((seq1 - q0 - 64 >= 64) ? 3 : 2);
        X.kg = QKVG + ((long)k0 + (lane >> 1)) * NQKVG + 2048 + kvh * 128 + 16 * wid + 8 * (lane & 1);
        { const int vrow = 8 * wid + (lane >> 4), v2 = vrow + 4;
          const int ch1 = (lane & 15) ^ (((vrow & 3) << 2) | ((vrow >> 2) & 3)), ch2 = (lane & 15) ^ (((v2 & 3) << 2) | ((v2 >> 2) & 3));
          X.vg = QKVG + ((long)k0 + vrow) * NQKVG + 2560 + kvh * 128 + 8 * ch1; X.vdelta = 4 * NQKVG + 8 * (ch2 - ch1); }
        X.gbase = QKVG; X.grow0 = q0 + sb * 32; X.gcol = 3072 + hq * 128;
        X.kbase = (unsigned)(r32 * 32 + hi * 16);
#pragma unroll
        for (int t = 0; t < 2; ++t) X.vb2[t] = 16384u + off_b(8 * t + 4 * hi + q4, 2 * blk + (p4 >> 1)) + 8 * (p4 & 1);
        const float m0 = sink[hq] * LOG2E;
        f32x16 o[4]; float l;
        attn_core<false>(X, qf, m0, o, l);
        { auto rr = __builtin_amdgcn_permlane32_swap(__float_as_uint(l), __float_as_uint(l), false, false); l = __uint_as_float(rr[0]) + __uint_as_float(rr[1]); }
        if (__builtin_amdgcn_ballot_w64(!(l < 1e30f)) != 0ull) { if (lane == 0) wgflag[0] = 1u; }
        __syncthreads();
        if (wgflag[0] != 0u) {
            { const bf16_t* qp = QKVG + (size_t)qrow * NQKVG + hq * 128 + hi * 8;
#pragma unroll
              for (int s = 0; s < 8; ++s) qf[s] = *(const bf16x8*)(qp + 16 * s); }
            attn_core<true>(X, qf, m0, o, l);
            auto rr = __builtin_amdgcn_permlane32_swap(__float_as_uint(l), __float_as_uint(l), false, false); l = __uint_as_float(rr[0]) + __uint_as_float(rr[1]);
        }
        if (unit + G < (MH / 64) * 4) {
            const int un = unit + G, qrow_n = (un >> 2) * 64 + sb * 32 + r32, hq_n = (un & 3) * 4 + hloc;
            const bf16_t* qp = QKVG + (size_t)qrow_n * NQKVG + hq_n * 128 + hi * 8;
#pragma unroll
            for (int s = 0; s < 8; ++s) qf[s] = *(const bf16x8*)(qp + 16 * s);
        }
        const float inv = 1.0f / l;
        LAS unsigned char* ostg = lds + 98304 + wid * 4096;
        const LAS unsigned char* gst = lds + (unsigned)((X.clast + 1 + (wid >> 2)) % 3) * 32768u + (unsigned)(wid & 3) * 8192u;
        bf16_t* obase = QKVG + (size_t)(q0 + sb * 32 + (lane >> 4)) * NQKVG + hq * 128 + (lane & 15) * 8;
#pragma unroll
        for (int half = 0; half < 2; ++half) {
            if ((r32 >> 4) == half) {
                const int rr = r32 & 15;
#pragma unroll
                for (int cc = 0; cc < 4; ++cc)
#pragma unroll
                    for (int g4 = 0; g4 < 4; ++g4) {
                        u32x2 w; w.x = cvt_pk_bf16(o[cc][4 * g4 + 0] * inv, o[cc][4 * g4 + 1] * inv); w.y = cvt_pk_bf16(o[cc][4 * g4 + 2] * inv, o[cc][4 * g4 + 3] * inv);
                        *(LAS u32x2*)(ostg + rr * 256 + (((4 * cc + g4) ^ rr) * 16) + 8 * hi) = w;
                    }
            }
            asm volatile("s_waitcnt lgkmcnt(0)" ::: "memory");
#pragma unroll
            for (int i = 0; i < 4; ++i) {
                const int rr = 4 * i + (lane >> 4), row = 16 * half + rr;
                const u32x4 ov = *(const LAS u32x4*)(ostg + rr * 256 + (((lane & 15) ^ rr) * 16));
                const u32x4 gw = *(const LAS u32x4*)(gst + row * 256 + (lane & 15) * 16);
                u32x4 w;
                w.x = cvt_pk_bf16(bf_lo(ov.x) * silu_f(bf_lo(gw.x)), bf_hi(ov.x) * silu_f(bf_hi(gw.x)));
                w.y = cvt_pk_bf16(bf_lo(ov.y) * silu_f(bf_lo(gw.y)), bf_hi(ov.y) * silu_f(bf_hi(gw.y)));
                w.z = cvt_pk_bf16(bf_lo(ov.z) * silu_f(bf_lo(gw.z)), bf_hi(ov.z) * silu_f(bf_hi(gw.z)));
                w.w = cvt_pk_bf16(bf_lo(ov.w) * silu_f(bf_lo(gw.w)), bf_hi(ov.w) * silu_f(bf_hi(gw.w)));
                *(u32x4*)(obase + (size_t)(row - (lane >> 4)) * NQKVG) = w;
            }
            asm volatile("s_waitcnt lgkmcnt(0)" ::: "memory");
        }
        __syncthreads();
    }
}
#undef ATT_DMA
#undef ASB

__device__ __forceinline__ float wave_sum(float v) {
#pragma unroll
    for (int o = 1; o < 64; o <<= 1) v += __shfl_xor(v, o);
    return v;
}
__device__ __forceinline__ unsigned f2bf(float f) { unsigned u = __builtin_bit_cast(unsigned, f); return (u + 0x7fffu + ((u >> 16) & 1u)) >> 16; }
__device__ __forceinline__ unsigned pk2(float lo, float hi) { return f2bf(lo) | (f2bf(hi) << 16); }

__device__ __forceinline__ void p0_transpose_item(const float* W, int K, int N, bf16_t* WT, int row_off, LAS float* scr, int item, int lane, int rope) {
    const int nblk = N / 32, kb = item / nblk, nb = item % nblk, k0 = 64 * kb, n0 = 32 * nb;
#pragma unroll 8
    for (int i = 0; i < 32; ++i) { const int kk = 2 * i + (lane >> 5); scr[kk * 33 + (lane & 31)] = W[(size_t)(k0 + kk) * N + n0 + (lane & 31)]; }
    asm volatile("s_waitcnt lgkmcnt(0)" ::: "memory");
    const bool perm = rope && ((n0 & 127) == 0) && (n0 < 2560);
    const int c = lane & 7;
#pragma unroll
    for (int j = 0; j < 4; ++j) { const int n = (lane >> 3) + 8 * j;
        const int src = perm ? (((n & 7) < 4) ? (4 * (n >> 3) + (n & 7)) : (16 + 4 * (n >> 3) + ((n & 7) - 4))) : n;
        const LAS float* s = scr + (8 * c) * 33 + src;
        u32x4 o; o.x = pk2(s[0 * 33], s[1 * 33]); o.y = pk2(s[2 * 33], s[3 * 33]); o.z = pk2(s[4 * 33], s[5 * 33]); o.w = pk2(s[6 * 33], s[7 * 33]);
        *(u32x4*)(WT + (size_t)(row_off + n0 + n) * K + k0 + 8 * c) = o; }
    asm volatile("s_waitcnt lgkmcnt(0)" ::: "memory");
}

__device__ __forceinline__ void sincos_d(double a, float& sn, float& cs) {
    const double kq = __builtin_rint(a * 0.63661977236758134308);
    double s = __builtin_fma(-kq, 1.57079632679489655800e+00, a); s = __builtin_fma(-kq, 6.12323399573676603587e-17, s);
    const int qi = ((int)kq) & 3;
    const double z = s * s;
    const double ps = s + s * z * (-1.0 / 6 + z * (1.0 / 120 + z * (-1.0 / 5040 + z * (1.0 / 362880 + z * (-1.0 / 39916800)))));
    const double pc = 1.0 + z * (-0.5 + z * (1.0 / 24 + z * (-1.0 / 720 + z * (1.0 / 40320 + z * (-1.0 / 3628800 + z * (1.0 / 479001600))))));
    const double sv = (qi == 0) ? ps : (qi == 1) ? pc : (qi == 2) ? -ps : -pc;
    const double cv = (qi == 0) ? pc : (qi == 1) ? -ps : (qi == 2) ? -pc : ps;
    sn = (float)sv; cs = (float)cv;
}

#define XB_TMO      128
#define XB_XCNT(j)  (256  + 64 * (j))
#define XB_XSUB(j)  (1280 + 64 * (j))
#define XB_XGEN(j)  (2304 + 64 * (j))
#define XB_TOP      3328
#define XB_TOPGEN   3392
#define XCD_BAR_WORDS 3456
#define XB_SPIN_CAP (1u << 18)
__device__ __forceinline__ unsigned xb_ld(unsigned* p)              { return __hip_atomic_load(p, __ATOMIC_RELAXED, __HIP_MEMORY_SCOPE_AGENT); }
__device__ __forceinline__ unsigned xb_add(unsigned* p, unsigned v) { return __hip_atomic_fetch_add(p, v, __ATOMIC_RELAXED, __HIP_MEMORY_SCOPE_AGENT); }
__device__ __forceinline__ unsigned xb_xcc_id() { return (unsigned)__builtin_amdgcn_s_getreg((3 << 11) | 20) & 0xFu; }
#define XB_SPIN(cond, bar) do { unsigned _sp = 0; while (cond) { __builtin_amdgcn_s_sleep(1); \
    if ((++_sp & 255u) == 0u) { if (xb_ld(&(bar)[XB_TMO])) break; if (_sp > XB_SPIN_CAP) { atomicAdd(&(bar)[XB_TMO], 1u); break; } } } } while (0)
struct XcdBarrier { unsigned* bar; unsigned x; volatile LAS unsigned* st; };
__device__ __forceinline__ XcdBarrier xcd_barrier_post(unsigned* bar, volatile LAS unsigned* st) {
    XcdBarrier b; b.bar = bar; b.x = xb_xcc_id(); b.st = st;
    if (threadIdx.x == 0) (void)xb_add(&bar[XB_XCNT(b.x)], 1u);
    return b;
}
__device__ __forceinline__ void xcd_barrier_complete(unsigned* bar, unsigned x, unsigned& nloc, unsigned& nx) {
    const unsigned G = gridDim.x * gridDim.y * gridDim.z;
    unsigned sum, cnt, mine, sp = 0u;
    for (;;) {
        sum = 0u; cnt = 0u; mine = 0u;
#pragma unroll
        for (unsigned j = 0; j < 16; ++j) { const unsigned c = xb_ld(&bar[XB_XCNT(j)]); sum += c; cnt += (c > 0u) ? 1u : 0u; mine = (j == x) ? c : mine; }
        if (sum == G) break;
        __builtin_amdgcn_s_sleep(1);
        if ((++sp & 255u) == 0u) { if (xb_ld(&bar[XB_TMO])) break; if (sp > XB_SPIN_CAP) { atomicAdd(&bar[XB_TMO], 1u); break; } }
    }
    nloc = mine > 0u ? mine : 1u; nx = cnt > 0u ? cnt : 1u;
}
__device__ __forceinline__ void xcd_barrier(const XcdBarrier& b) {
    asm volatile("s_waitcnt vmcnt(0)" ::: "memory");
    __syncthreads();
    if (threadIdx.x == 0) {
        unsigned* bar = b.bar;
        __builtin_amdgcn_s_waitcnt(0);
        unsigned nloc = b.st[0], nx = b.st[1];
        if (nloc == 0u) { xcd_barrier_complete(bar, b.x, nloc, nx); b.st[0] = nloc; b.st[1] = nx; }
        const unsigned old = xb_add(&bar[XB_XSUB(b.x)], 1u);
        const unsigned gen = old / nloc;
        if (old + 1u == (gen + 1u) * nloc) {
            __builtin_amdgcn_fence(__ATOMIC_RELEASE, "agent");
            asm volatile("s_waitcnt vmcnt(0)" ::: "memory");
            const unsigned og = xb_add(&bar[XB_TOP], 1u);
            const unsigned tg = og / nx;
            if (og + 1u == (tg + 1u) * nx) xb_add(&bar[XB_TOPGEN], 1u);
            else XB_SPIN(xb_ld(&bar[XB_TOPGEN]) == tg, bar);
            __builtin_amdgcn_fence(__ATOMIC_ACQUIRE, "agent");
            xb_add(&bar[XB_XGEN(b.x)], 1u);
            asm volatile("s_waitcnt vmcnt(0)" ::: "memory");
        } else {
            XB_SPIN(xb_ld(&bar[XB_XGEN(b.x)]) == gen, bar);
            __builtin_amdgcn_fence(__ATOMIC_ACQUIRE, "agent");
            asm volatile("s_waitcnt vmcnt(0)" ::: "memory");
        }
    }
    __syncthreads();
}

struct Args { const float* in[11]; float* out; unsigned char* ws; int ph_lo, ph_hi; unsigned char seq[64]; };
constexpr int LDS_BYTES = 135168;

__global__ void __launch_bounds__(512) mega_fwd(Args args) {
    extern __shared__ __attribute__((aligned(16))) unsigned char lds_raw[];
    LAS unsigned char* lds = (LAS unsigned char*)lds_raw;
    cg::grid_group grid = cg::this_grid();
    volatile LAS unsigned* MISC = (volatile LAS unsigned*)(lds + 131072 + 256);
    if (threadIdx.x < 4) MISC[threadIdx.x] = 0u;
    __syncthreads();
    const XcdBarrier xbar = xcd_barrier_post((unsigned*)args.ws, MISC);

    if (args.ph_lo == 0) {
        int tid_ = threadIdx.x; asm volatile("" : "+v"(tid_));
        const int tid = tid_, lane = tid & 63, wave = __builtin_amdgcn_readfirstlane(tid >> 6);
        const int G = gridDim.x, bid = blockIdx.x, gw = bid * 8 + wave, NGW = G * 8;
        unsigned char* ws = args.ws;
        bf16_t* WinT = (bf16_t*)(ws + WS_WIN); bf16_t* WoT = (bf16_t*)(ws + WS_WO); bf16_t* PinT = (bf16_t*)(ws + WS_PIN);
        bf16_t* WgT = (bf16_t*)(ws + WS_WG); bf16_t* PoT = (bf16_t*)(ws + WS_PO); float* CS = (float*)(ws + WS_CS);
                LAS float* scr = (LAS float*)(lds + wave * 16384);
                constexpr int I_IN = 16 * 160, I_WO = 32 * 32, I_PIN = 16 * 128, I_WG = 8 * 16, I_PO = 32 * 32;
                constexpr int NITEMS = I_IN + I_WO + I_PIN + 4 * I_WG + I_PO;
                for (int it = gw; it < NITEMS; it += NGW) {
                    int r = it;
                    if (r < I_IN) { p0_transpose_item(args.in[4], 1024, 5120, WinT, 0, scr, r, lane, 1); continue; } r -= I_IN;
                    if (r < I_WO) { p0_transpose_item(args.in[6], 2048, 1024, WoT, 0, scr, r, lane, 0); continue; } r -= I_WO;
                    if (r < I_PIN) { p0_transpose_item(args.in[7], 1024, 4096, PinT, 0, scr, r, lane, 0); continue; } r -= I_PIN;
                    if (r < 4 * I_WG) { const int g = r / I_WG; p0_transpose_item(args.in[8] + (size_t)g * 512 * 512, 512, 512, WgT, g * 512, scr, r % I_WG, lane, 0); continue; } r -= 4 * I_WG;
                    p0_transpose_item(args.in[10], 2048, 1024, PoT, 0, scr, r, lane, 0);
                }
                for (int i = bid * 512 + tid; i < 16384 * 16; i += G * 512) {
                    const int pos = i >> 4, f = i & 15;
                    const float invf = (float)exp(-(double)f * (1.0 / 16.0) * 13.122363377404328);
                    const float ang = (float)pos * invf;
                    float sn, cs; sincos_d((double)ang, sn, cs);
                    CS[pos * 32 + f] = cs; CS[pos * 32 + 16 + f] = sn;
                }
            }
    for (int ph = args.ph_lo; ph < args.ph_hi; ++ph) {
        int tid_ = threadIdx.x; asm volatile("" : "+v"(tid_));
        const int tid = tid_, lane = tid & 63, wave = __builtin_amdgcn_readfirstlane(tid >> 6);
        const int G = gridDim.x, bid = blockIdx.x;
        const int gw = bid * 8 + wave, NGW = G * 8;
        size_t zoff = 0; asm volatile("" : "+s"(zoff));
        unsigned char* ws = args.ws + zoff;
    bf16_t* WinT = (bf16_t*)(ws + WS_WIN); bf16_t* WoT = (bf16_t*)(ws + WS_WO); bf16_t* PinT = (bf16_t*)(ws + WS_PIN);
    bf16_t* WgT = (bf16_t*)(ws + WS_WG); bf16_t* PoT = (bf16_t*)(ws + WS_PO);
    float* CS = (float*)(ws + WS_CS); float* SS0 = (float*)(ws + WS_SS0); float* SS1 = (float*)(ws + WS_SS1);
    bf16_t* XN = (bf16_t*)(ws + WS_XN); bf16_t* BIG = (bf16_t*)(ws + WS_BIG); bf16_t* POOL = (bf16_t*)(ws + WS_POOL); bf16_t* OUTB = (bf16_t*)(ws + WS_OUT);
    bf16_t* XN0A = (bf16_t*)(args.out + (size_t)32768 * DM);
    bf16_t* X1B = (bf16_t*)(ws + WS_X1);
    const float* npre = args.in[2]; const float* npost = args.in[3];
        const int code = args.seq[ph], part = (code == 255) ? 0 : code / 10, k = code == 255 ? 10 : code % 10;
        const int grow0 = part * MH;
        const float* xin = (grow0 < 32768) ? args.in[0] + (size_t)grow0 * DM : args.in[1] + (size_t)(grow0 - 32768) * DM;
        float* yout = args.out + (size_t)grow0 * DM;
        const int S = (grow0 < 32768) ? 16384 : 2048;
        if (k == 0) {
            for (int row = gw * 2; row < 65536; row += NGW * 2) {
                f32x4 v[2][4]; float sq[2];
                const float* xsrc = (row < 32768) ? args.in[0] + (size_t)row * DM : args.in[1] + (size_t)(row - 32768) * DM;
#pragma unroll
                for (int rr = 0; rr < 2; ++rr) { const f32x4* xr = (const f32x4*)(xsrc + (size_t)rr * DM) + lane;
#pragma unroll
                    for (int j = 0; j < 4; ++j) v[rr][j] = __builtin_nontemporal_load(xr + 64 * j); }
#pragma unroll
                for (int rr = 0; rr < 2; ++rr) { float s = 0.f;
#pragma unroll
                    for (int j = 0; j < 4; ++j) s += (v[rr][j].x * v[rr][j].x + v[rr][j].y * v[rr][j].y) + (v[rr][j].z * v[rr][j].z + v[rr][j].w * v[rr][j].w);
                    sq[rr] = s; }
#pragma unroll
                for (int rr = 0; rr < 2; ++rr) {
                    const float rstd = 1.0f / sqrtf(wave_sum(sq[rr]) * (1.0f / DM) + NORM_EPS);
                    u32x2* o8 = (u32x2*)(XN0A + (size_t)(row + rr) * DM) + lane;
#pragma unroll
                    for (int j = 0; j < 4; ++j) { const f32x4 gg = *((const f32x4*)npre + lane + 64 * j);
                        u32x2 w; w.x = pk2(v[rr][j].x * rstd * gg.x, v[rr][j].y * rstd * gg.y); w.y = pk2(v[rr][j].z * rstd * gg.z, v[rr][j].w * rstd * gg.w); o8[64 * j] = w; }
                }
            }
        } else if (k == 1 || k == 3 || k == 5 || k == 7 || k == 8) {
            pg8::Gemm g; pg8::Order O; pg8::Epi E;
            O.G = G; O.c = bid; O.grouped = 0;
            E.cs = CS; E.smask = S - 1; E.ss = SS0; E.scale = args.in[9];
            if (k == 1) { g.A = XN0A + (size_t)grow0 * DM; g.lda = 1024; g.Bt = WinT; g.K = 1024; O.nM = MH / 256; O.nN = NQKVG / 256; E.mode = 0; E.O = BIG; E.ldc = NQKVG; }
            else if (k == 3) { g.A = BIG; g.lda = NQKVG; g.Bt = WoT; g.K = 2048; O.nM = MH / 256; O.nN = 4; E.mode = 2; E.O = OUTB; E.ldc = 1024; E.ss = SS0; }
            else if (k == 5) { g.A = XN; g.lda = 1024; g.Bt = PinT; g.K = 1024; O.nM = MH / 256; O.nN = NUG / 256; E.mode = 1; E.O = BIG; E.ldc = NUG; }
            else if (k == 7) { g.A = POOL; g.lda = 512; g.Bt = WgT; g.K = 512; O.nM = 4 * (MH / 256); O.nN = 2; O.grouped = 1; E.mode = 3; E.O = BIG; E.ldc = NUG; }
            else { g.A = BIG; g.lda = NUG; g.Bt = PoT; g.K = 2048; O.nM = MH / 256; O.nN = 4; E.mode = 2; E.O = OUTB; E.ldc = 1024; E.ss = SS1; }
            O.nwg = O.nM * O.nN;
            pg8::gemm_phase(lds, g, O, E);
        } else if (k == 2) {
            attn_phase(lds, BIG, args.in[5], S, G, bid);
        } else if (k == 4 || k == 9) {
            const float* ssp = (k == 4) ? SS0 : SS1;
            const float* gpost = npost + ((k == 4) ? 0 : DM);
            for (int row = gw * 2; row < MH; row += NGW * 2) {
                f32x4 v[2][4]; u32x2 ow[2][4]; float rs[2], sq[2];
#pragma unroll
                for (int rr = 0; rr < 2; ++rr) {
                    const u32x2* orow = (const u32x2*)(OUTB + (size_t)(row + rr) * DM) + lane;
                    if (k == 4) { const f32x4* xr = (const f32x4*)(xin + (size_t)(row + rr) * DM) + lane;
#pragma unroll
                        for (int j = 0; j < 4; ++j) v[rr][j] = __builtin_nontemporal_load(xr + 64 * j); }
                    else { const u32x2* xb = (const u32x2*)(X1B + (size_t)(row + rr) * DM) + lane;
#pragma unroll
                        for (int j = 0; j < 4; ++j) { const u32x2 w = xb[64 * j]; v[rr][j] = (f32x4){bf_lo(w.x), bf_hi(w.x), bf_lo(w.y), bf_hi(w.y)}; } }
#pragma unroll
                    for (int j = 0; j < 4; ++j) ow[rr][j] = orow[64 * j];
                    rs[rr] = (lane < 16) ? ssp[(size_t)(row + rr) * 16 + lane] : 0.f;
                }
#pragma unroll
                for (int rr = 0; rr < 2; ++rr) {
                    float sp = rs[rr];
                    sp += __shfl_xor(sp, 1); sp += __shfl_xor(sp, 2); sp += __shfl_xor(sp, 4); sp += __shfl_xor(sp, 8);
                    const float r1 = 1.0f / sqrtf(__shfl(sp, 0) * (1.0f / DM) + NORM_EPS);
                    float s = 0.f;
#pragma unroll
                    for (int j = 0; j < 4; ++j) {
                        const f32x4 gg = *((const f32x4*)gpost + lane + 64 * j); const f32x4 xv = v[rr][j]; const u32x2 w = ow[rr][j];
                        f32x4 y; y.x = xv.x + bf_lo(w.x) * r1 * gg.x; y.y = xv.y + bf_hi(w.x) * r1 * gg.y; y.z = xv.z + bf_lo(w.y) * r1 * gg.z; y.w = xv.w + bf_hi(w.y) * r1 * gg.w;
                        v[rr][j] = y; s += (y.x * y.x + y.y * y.y) + (y.z * y.z + y.w * y.w);
                    }
                    sq[rr] = s;
                    if (k == 4) { u32x2* xb = (u32x2*)(X1B + (size_t)(row + rr) * DM) + lane;
#pragma unroll
                        for (int j = 0; j < 4; ++j) { u32x2 w; w.x = pk2(v[rr][j].x, v[rr][j].y); w.y = pk2(v[rr][j].z, v[rr][j].w); xb[64 * j] = w; } }
                    else { f32x4* yr = (f32x4*)(yout + (size_t)(row + rr) * DM) + lane;
#pragma unroll
                        for (int j = 0; j < 4; ++j) __builtin_nontemporal_store(v[rr][j], yr + 64 * j); }
                }
                if (k == 4) {
#pragma unroll
                    for (int rr = 0; rr < 2; ++rr) {
                        const float rstd = 1.0f / sqrtf(wave_sum(sq[rr]) * (1.0f / DM) + NORM_EPS);
                        u32x2* o8 = (u32x2*)(XN + (size_t)(row + rr) * DM) + lane;
#pragma unroll
                        for (int j = 0; j < 4; ++j) { const f32x4 gg = *((const f32x4*)(npre + DM) + lane + 64 * j);
                            u32x2 w; w.x = pk2(v[rr][j].x * rstd * gg.x, v[rr][j].y * rstd * gg.y); w.y = pk2(v[rr][j].z * rstd * gg.z, v[rr][j].w * rstd * gg.w); o8[64 * j] = w; }
                    }
                }
            }
        } else if (k == 6) {
            const int cc = tid & 255, tsub = tid >> 8, g = cc >> 6, hw = 1 << g;
            for (int blkI = bid; blkI < MH / 64; blkI += G) {
                const int t0 = blkI * 64 + tsub * 32, seq0 = t0 & ~(S - 1), seqL = seq0 + S - 1;
                const bf16_t* ub = BIG + cc * 8;
                float sum[8];
#pragma unroll
                for (int e = 0; e < 8; ++e) sum[e] = 0.f;
                { const int lo = max(t0 - hw, seq0), hi2 = min(t0 + hw - 1, seqL);
                  for (int j = lo; j <= hi2; ++j) { const u32x4 w = *(const u32x4*)(ub + (size_t)j * NUG);
                      sum[0] += bf_lo(w.x); sum[1] += bf_hi(w.x); sum[2] += bf_lo(w.y); sum[3] += bf_hi(w.y); sum[4] += bf_lo(w.z); sum[5] += bf_hi(w.z); sum[6] += bf_lo(w.w); sum[7] += bf_hi(w.w); } }
                bf16_t* pb = POOL + ((size_t)g * MH) * 512 + (cc & 63) * 8;
                for (int t = t0; t < t0 + 32; t += 4) {
                    u32x4 cw[4], ew[4], lw[4];
#pragma unroll
                    for (int i = 0; i < 4; ++i) {
                        cw[i] = *(const u32x4*)(ub + (size_t)(t + i) * NUG);
                        ew[i] = *(const u32x4*)(ub + (size_t)min(t + i + hw, seqL) * NUG);
                        lw[i] = *(const u32x4*)(ub + (size_t)max(t + i - hw, seq0) * NUG);
                    }
#pragma unroll
                    for (int i = 0; i < 4; ++i) {
                        const int tt = t + i, lo = max(tt - hw, seq0), hi2 = min(tt + hw - 1, seqL);
                        const float rc = 1.0f / (float)(hi2 - lo + 1);
                        const u32x4 w = cw[i];
                        u32x4 o;
                        o.x = cvt_pk_bf16(sum[0] * rc - bf_lo(w.x), sum[1] * rc - bf_hi(w.x)); o.y = cvt_pk_bf16(sum[2] * rc - bf_lo(w.y), sum[3] * rc - bf_hi(w.y));
                        o.z = cvt_pk_bf16(sum[4] * rc - bf_lo(w.z), sum[5] * rc - bf_hi(w.z)); o.w = cvt_pk_bf16(sum[6] * rc - bf_lo(w.w), sum[7] * rc - bf_hi(w.w));
                        *(u32x4*)(pb + (size_t)tt * 512) = o;
                        const float fe = (tt + hw <= seqL) ? 1.0f : 0.0f, fl = (tt - hw >= seq0) ? 1.0f : 0.0f;
                        const u32x4 a = ew[i], d = lw[i];
                        sum[0] += fe * bf_lo(a.x) - fl * bf_lo(d.x); sum[1] += fe * bf_hi(a.x) - fl * bf_hi(d.x); sum[2] += fe * bf_lo(a.y) - fl * bf_lo(d.y); sum[3] += fe * bf_hi(a.y) - fl * bf_hi(d.y);
                        sum[4] += fe * bf_lo(a.z) - fl * bf_lo(d.z); sum[5] += fe * bf_hi(a.z) - fl * bf_hi(d.z); sum[6] += fe * bf_lo(a.w) - fl * bf_lo(d.w); sum[7] += fe * bf_hi(a.w) - fl * bf_hi(d.w);
                    }
                }
            }
        }
        if (ph + 1 < args.ph_hi) { if (args.ph_lo > ph) grid.sync(); else xcd_barrier(xbar); }
    }
}

extern "C" void kernel_launch(void* const* d_in, const int* in_sizes, int n_in, void* d_out, int out_size, void* d_ws, size_t ws_size, hipStream_t stream) {
    static int grid = 0;
    if (grid == 0) {
        if (n_in != 11 || ws_size < WS_END) { fprintf(stderr, "kernel_launch: unexpected n_in %d / ws_size %zu\n", n_in, ws_size); grid = -1; return; }
        int dev = 0, cus = 0, per_cu = 0;
        hipGetDevice(&dev);
        hipDeviceGetAttribute(&cus, hipDeviceAttributeMultiprocessorCount, dev);
        if (hipFuncSetAttribute((const void*)mega_fwd, hipFuncAttributeMaxDynamicSharedMemorySize, LDS_BYTES) != hipSuccess) { fprintf(stderr, "kernel_launch: hipFuncSetAttribute failed\n"); grid = -1; return; }
        if (hipOccupancyMaxActiveBlocksPerMultiprocessor(&per_cu, (const void*)mega_fwd, 512, LDS_BYTES) != hipSuccess || per_cu < 1) { fprintf(stderr, "kernel_launch: occupancy query gave %d\n", per_cu); per_cu = 1; }
        (void)hipGetLastError();
        grid = cus;
    }
    if (grid < 0) return;
    if (hipMemsetAsync(d_ws, 0, 16384, stream) != hipSuccess) { fprintf(stderr, "kernel_launch: memset failed\n"); return; }
    Args a{};
    for (int i = 0; i < 11; ++i) a.in[i] = (const float*)d_in[i];
    a.out = (float*)d_out; a.ws = (unsigned char*)d_ws; a.ph_lo = 0;
    { int n = 0;
#ifndef REP_MASK
#define REP_MASK 0
#endif
#ifndef REP_ATTN
#define REP_ATTN 0
#endif
#ifndef EXTRA_SYNCS
#define EXTRA_SYNCS 0
#endif
      for (int h = 0; h < NPART; ++h) for (int k = (h == 0 ? 0 : 1); k < 10; ++k) { a.seq[n++] = (unsigned char)(h * 10 + k); if ((REP_MASK >> k) & 1) a.seq[n++] = (unsigned char)(h * 10 + k);
          if (k == 2 && REP_ATTN) { a.seq[n++] = (unsigned char)(h * 10 + 1); a.seq[n++] = (unsigned char)(h * 10 + 2); } }
      for (int i = 0; i < EXTRA_SYNCS; ++i) a.seq[n++] = 255;
      a.ph_hi = n; }
    void* kargs[] = {&a};
    hipError_t e = hipLaunchCooperativeKernel((const void*)mega_fwd, dim3(grid), dim3(512), kargs, LDS_BYTES, stream);
    if (e != hipSuccess) fprintf(stderr, "cooperative launch failed: %s (grid %d)\n", hipGetErrorString(e), grid);
}
```
